# Optimizing an MI355X kernel written in HIP

```python
import math
import jax, jax.numpy as jnp
from jax import lax
import numpy as np

D_MODEL = 1024
BATCH = 4
SEQ = 4096
DEPTH = 4
DEC_BATCH = 8
DEC_SEQ = 16
PAST_LEN = 4096

CHUNK = 64
Q_BLOCK = 128
N_EVEN = (DEPTH + 1) // 2
N_ODD = DEPTH // 2
D_A = D_MODEL
D_B = D_MODEL
CONV_W = 31
HB_DK = 128
HB_HEADS = D_B // HB_DK
HB_DV = D_B // HB_HEADS
D_C = 2 * D_MODEL
HC_HEADS = 16
HC_DIM = D_C // HC_HEADS // 2
IN_EVEN = 3 * D_A + 4 * D_B
IN_ODD = 4 * D_C
ALPHA = (2.0 * DEPTH) ** 0.25
BETA = (8.0 * DEPTH) ** -0.25
EPS = 1e-5

kernel_name = "hybrid_stream_conv_hgrn2_diffattn_step"


def layer_norm(x, g, b):
    xf = x.astype(jnp.float32)
    mu = jnp.mean(xf, axis=-1, keepdims=True)
    var = jnp.mean(jnp.square(xf - mu), axis=-1, keepdims=True)
    return ((xf - mu) * lax.rsqrt(var + EPS) * g.astype(jnp.float32) + b.astype(jnp.float32)).astype(x.dtype)


def rms_norm(x, g):
    xf = x.astype(jnp.float32)
    y = xf * lax.rsqrt(jnp.mean(jnp.square(xf), axis=-1, keepdims=True) + EPS)
    return (y * g.astype(jnp.float32)).astype(x.dtype)


def causal_depthwise_conv(u, buf, w, b):
    full = jnp.concatenate([buf.astype(u.dtype), u], axis=1)
    y = lax.conv_general_dilated(full, w[:, None, :].astype(u.dtype), window_strides=(1,), padding='VALID',
                                 dimension_numbers=('NWC', 'WIO', 'NWC'), feature_group_count=u.shape[-1])
    return y + b.astype(u.dtype), full[:, -(CONV_W - 1):]


def hgrn2_recurrence(q, k, v, logf, S0):
    Bsz, T, H, K = q.shape
    V = v.shape[-1]
    chunk = CHUNK if T % CHUNK == 0 else T
    n = T // chunk

    def blocks(a):
        return jnp.moveaxis(a.reshape(Bsz, n, chunk, *a.shape[2:]), 1, 0)

    tri = jnp.tril(jnp.ones((chunk, chunk), dtype=bool))[None, :, :, None, None]

    def step(S, inp):
        qc, kc, vc, gc = inp
        b = jnp.cumsum(gc, axis=1)
        o_inter = jnp.einsum('blhk,bhkv->blhv', qc * jnp.exp(b), S)
        diff = b[:, :, None] - b[:, None, :]
        decay = jnp.exp(jnp.where(tri, diff, -jnp.inf))
        att = jnp.einsum('bthk,btshk,bshk->btsh', qc, decay, kc)
        o = o_inter + jnp.einsum('btsh,bshv->bthv', att, vc)
        b_last = b[:, -1]
        S_new = jnp.exp(b_last)[..., None] * S + jnp.einsum(
            'bshk,bshv->bhkv', kc * jnp.exp(b_last[:, None] - b), vc)
        return S_new, o

    S, o = lax.scan(step, S0.astype(jnp.float32), (blocks(q), blocks(k), blocks(v), blocks(logf)))
    o = jnp.moveaxis(o, 0, 1).reshape(Bsz, T, H, V)
    return o, S


def even_mixer(x, conv_buf, S0, w_in, w_out, conv_w, conv_b, cln_g, cln_b, lb, hn_g):
    Bsz, T, _ = x.shape
    h = x @ w_in
    cuts = [D_A, 2 * D_A, 3 * D_A, 3 * D_A + D_B, 3 * D_A + 2 * D_B, 3 * D_A + 3 * D_B]
    a, ga, za, q, fr, i, zb = jnp.split(h, cuts, axis=-1)
    u = a * jax.nn.sigmoid(ga)
    c, new_buf = causal_depthwise_conv(u, conv_buf, conv_w, conv_b)
    c = jax.nn.silu(layer_norm(c, cln_g, cln_b))
    out_a = c * jax.nn.silu(za)
    hs = (Bsz, T, HB_HEADS, HB_DK)
    frf = fr.astype(jnp.float32).reshape(hs)
    lbh = lb.astype(jnp.float32).reshape(HB_HEADS, HB_DK)
    logf = jnp.logaddexp(jnp.log(lbh), jnp.log1p(-lbh) + jax.nn.log_sigmoid(frf))
    kk = (1.0 - lbh) * jax.nn.sigmoid(-frf)
    qq = jax.nn.silu(q.astype(jnp.float32)).reshape(hs)
    vv = i.astype(jnp.float32).reshape(Bsz, T, HB_HEADS, HB_DV)
    o, S = hgrn2_recurrence(qq, kk, vv, logf, S0)
    o = rms_norm(o, hn_g).astype(x.dtype).reshape(Bsz, T, D_B)
    out_b = o * jax.nn.silu(zb)
    y = jnp.concatenate([out_a, out_b], axis=-1) @ w_out
    return y, new_buf, S


def diff_attend(q, k, v, q_pos, k_pos, lam):
    s = jnp.einsum('bqhcd,bkhcd->bhcqk', q, k).astype(jnp.float32) * (HC_DIM ** -0.5)
    mask = (k_pos[None, :] // CHUNK) <= (q_pos[:, None] // CHUNK)
    p = jax.nn.softmax(jnp.where(mask, s, -jnp.inf), axis=-1)
    p = p[:, :, 0] - lam * p[:, :, 1]
    return jnp.einsum('bhqk,bkhe->bqhe', p.astype(v.dtype), v)


def odd_mixer(x, k_past, v_past, w_in, w_out, lq1, lk1, lq2, lk2, sub_g, lam_init):
    Bsz, T, _ = x.shape
    q, k, v, z = jnp.split(x @ w_in, 4, axis=-1)
    q = q.reshape(Bsz, T, HC_HEADS, 2, HC_DIM)
    k = k.reshape(Bsz, T, HC_HEADS, 2, HC_DIM)
    v = v.reshape(Bsz, T, HC_HEADS, 2 * HC_DIM)
    f32 = jnp.float32
    lam = (jnp.exp(jnp.sum(lq1.astype(f32) * lk1.astype(f32))) - jnp.exp(jnp.sum(lq2.astype(f32) * lk2.astype(f32)))
           + lam_init)
    if k_past is None:
        nb = T // Q_BLOCK
        qb = jnp.moveaxis(q.reshape(Bsz, nb, Q_BLOCK, HC_HEADS, 2, HC_DIM), 1, 0)
        k_pos = jnp.arange(T)

        def one(args):
            qi, start = args
            return diff_attend(qi, k, v, start + jnp.arange(Q_BLOCK), k_pos, lam)

        o = lax.map(one, (qb, jnp.arange(nb) * Q_BLOCK))
        o = jnp.moveaxis(o, 0, 1).reshape(Bsz, T, HC_HEADS, 2 * HC_DIM)
    else:
        P = k_past.shape[1]
        k_all = jnp.concatenate([k_past.astype(k.dtype).reshape(Bsz, P, HC_HEADS, 2, HC_DIM), k], axis=1)
        v_all = jnp.concatenate([v_past.astype(v.dtype), v], axis=1)
        o = diff_attend(q, k_all, v_all, P + jnp.arange(T), jnp.arange(P + T), lam)
    o = rms_norm(o, sub_g) * (1.0 - lam_init)
    o = o.reshape(Bsz, T, D_C) * jax.nn.silu(z)
    return o @ w_out, k.reshape(Bsz, T, HC_HEADS, 2 * HC_DIM), v


def setup_inputs(seed: int = 0) -> dict:
    key = jax.random.key(seed)
    ks = jax.random.split(key, 24)
    nrm = jax.random.normal
    f32 = jnp.float32
    return {
        "x_prompt": nrm(ks[0], (BATCH, SEQ, D_MODEL), f32),
        "x_sample": nrm(ks[1], (DEC_BATCH, DEC_SEQ, D_MODEL), f32),
        "state_conv": 0.5 * nrm(ks[2], (N_EVEN, DEC_BATCH, CONV_W - 1, D_A), f32),
        "state_hgrn": 0.5 * nrm(ks[3], (N_EVEN, DEC_BATCH, HB_HEADS, HB_DK, HB_DV), f32),
        "cache_k": nrm(ks[4], (N_ODD, DEC_BATCH, PAST_LEN, HC_HEADS, 2 * HC_DIM), f32),
        "cache_v": nrm(ks[5], (N_ODD, DEC_BATCH, PAST_LEN, HC_HEADS, 2 * HC_DIM), f32),
        "w_in_even": nrm(ks[6], (N_EVEN, D_MODEL, IN_EVEN), f32) * D_MODEL ** -0.5,
        "w_out_even": nrm(ks[7], (N_EVEN, D_A + D_B, D_MODEL), f32) * (D_A + D_B) ** -0.5 * BETA,
        "conv_w": nrm(ks[8], (N_EVEN, CONV_W, D_A), f32) * CONV_W ** -0.5,
        "conv_b": 0.01 * nrm(ks[9], (N_EVEN, D_A), f32),
        "conv_ln_g": 1.0 + 0.02 * nrm(ks[10], (N_EVEN, D_A), f32),
        "conv_ln_b": 0.02 * nrm(ks[11], (N_EVEN, D_A), f32),
        "hgrn_lb_logits": nrm(ks[12], (N_EVEN, D_B), f32),
        "hgrn_norm_g": 1.0 + 0.02 * nrm(ks[13], (N_EVEN, HB_DV), f32),
        "w_in_odd": nrm(ks[14], (N_ODD, D_MODEL, IN_ODD), f32) * D_MODEL ** -0.5,
        "w_out_odd": nrm(ks[15], (N_ODD, D_C, D_MODEL), f32) * D_C ** -0.5 * BETA,
        "lam_q1": 0.1 * nrm(ks[16], (N_ODD, HC_DIM), f32),
        "lam_k1": 0.1 * nrm(ks[17], (N_ODD, HC_DIM), f32),
        "lam_q2": 0.1 * nrm(ks[18], (N_ODD, HC_DIM), f32),
        "lam_k2": 0.1 * nrm(ks[19], (N_ODD, HC_DIM), f32),
        "subln_g": 1.0 + 0.02 * nrm(ks[20], (N_ODD, 2 * HC_DIM), f32),
        "post_ln_g": 1.0 + 0.02 * nrm(ks[21], (DEPTH, D_MODEL), f32),
        "post_ln_b": 0.02 * nrm(ks[22], (DEPTH, D_MODEL), f32),
    }


def reference(x_prompt, x_sample, state_conv, state_hgrn, cache_k, cache_v, w_in_even, w_out_even, conv_w, conv_b,
              conv_ln_g, conv_ln_b, hgrn_lb_logits, hgrn_norm_g, w_in_odd, w_out_odd, lam_q1, lam_k1, lam_q2, lam_k2,
              subln_g, post_ln_g, post_ln_b):
    lb_cum = jnp.cumsum(jax.nn.softmax(hgrn_lb_logits.astype(jnp.float32), axis=0), axis=0)
    lb_all = lb_cum - lb_cum[0:1]
    xp, xs = x_prompt, x_sample
    bp = xp.shape[0]
    conv_p, hgrn_p, k_p, v_p = [], [], [], []
    conv_s, hgrn_s, k_s, v_s = [], [], [], []
    for l in range(DEPTH):
        if l % 2 == 0:
            e = l // 2
            prm = (w_in_even[e], w_out_even[e], conv_w[e], conv_b[e], conv_ln_g[e], conv_ln_b[e], lb_all[e],
                   hgrn_norm_g[e])
            buf0 = jnp.zeros((bp, CONV_W - 1, D_A), xp.dtype)
            S0 = jnp.zeros((bp, HB_HEADS, HB_DK, HB_DV), jnp.float32)
            yp, cb_p, S_p = even_mixer(xp, buf0, S0, *prm)
            ys, cb_s, S_s = even_mixer(xs, state_conv[e], state_hgrn[e], *prm)
            conv_p.append(cb_p); hgrn_p.append(S_p)
            conv_s.append(cb_s); hgrn_s.append(S_s)
        else:
            o = l // 2
            lam_init = 0.8 - 0.6 * math.exp(-0.3 * l)
            prm = (w_in_odd[o], w_out_odd[o], lam_q1[o], lam_k1[o], lam_q2[o], lam_k2[o], subln_g[o], lam_init)
            yp, kn_p, vn_p = odd_mixer(xp, None, None, *prm)
            ys, kn_s, vn_s = odd_mixer(xs, cache_k[o], cache_v[o], *prm)
            k_p.append(kn_p); v_p.append(vn_p)
            k_s.append(kn_s); v_s.append(vn_s)
        xp = layer_norm(ALPHA * xp + yp, post_ln_g[l], post_ln_b[l])
        xs = layer_norm(ALPHA * xs + ys, post_ln_g[l], post_ln_b[l])
    return (xp, xs, jnp.stack(conv_p), jnp.stack(hgrn_p), jnp.stack(k_p), jnp.stack(v_p),
            jnp.stack(conv_s), jnp.stack(hgrn_s), jnp.stack(k_s), jnp.stack(v_s))
```

```cpp
#include <hip/hip_runtime.h>
#include <cstdio>
#include <cstdint>
namespace pg8 {
#define PG8_LAS __attribute__((address_space(3)))
typedef unsigned short bf16_t;
typedef short bf16x8 __attribute__((ext_vector_type(8)));
typedef float f32x4 __attribute__((ext_vector_type(4)));
typedef unsigned u32x4 __attribute__((ext_vector_type(4)));
constexpr int BM = 256, BK = 64, HALF = 128, HTB = HALF * BK * 2  , STAGE_BYTES = 8 * HTB, NXCD = 8, WGM = 8;

__host__ __device__ __forceinline__ int lds_byte(int r, int c) { const int st = (r >> 4) * 2 + (c >> 5), rr = r & 15, cc = c & 31, ob = rr * 64 + cc * 2; return st * 1024 + (ob ^ (((ob >> 9) & 1) << 5)); }
__host__ __device__ __forceinline__ void stage_rc(int b, int& R, int& C) { const int st = b / 1024, sb = b % 1024, swz = sb ^ (((sb >> 9) & 1) << 5); R = (st >> 1) * 16 + swz / 64; C = (st & 1) * 32 + (swz % 64) / 2; }
__host__ __device__ __forceinline__ int perm32(int rho) { const int n = rho >> 4, i = rho & 15; return 8 * (i >> 2) + 4 * n + (i & 3); }

struct Unit { int pm, pn; };
struct Gemm { const bf16_t* A; const bf16_t* Bt; int M, N, K; };

struct StaticOrder {
    int nM, nN, nwg, G, c;
    __host__ __device__ void init(int M, int N, int G_, int c_) { nM = M / BM; nN = N / BM; nwg = nM * nN; G = G_; c = c_; }
    __host__ __device__ bool next(int i, Unit& u) const {
        const long L = (long)i * G + c; if (L >= nwg) return false;
        int wgid = (int)L; { const int q = nwg / NXCD, r = nwg % NXCD, xcd = wgid % NXCD, off = wgid / NXCD; wgid = (xcd < r ? xcd * (q + 1) : r * (q + 1) + (xcd - r) * q) + off; }
        const int nig = WGM * nN, gid = wgid / nig, fm = gid * WGM, gsz = (nM - fm) < WGM ? (nM - fm) : WGM;
        u.pm = fm + ((wgid % nig) % gsz); u.pn = (wgid % nig) / gsz; return true;
    }
    __device__ __forceinline__ void a_ready(const Unit&) const {}
    __device__ __forceinline__ void done(const Unit&) const {}
};
__device__ __forceinline__ unsigned cvt_pk_bf16(float lo, float hi) { unsigned r; asm volatile("v_cvt_pk_bf16_f32 %0, %1, %2" : "=v"(r) : "v"(lo), "v"(hi)); return r; }
typedef float f32x2 __attribute__((ext_vector_type(2)));
struct EpiPlain {
    static constexpr bool PERM = true, AFTER_DRAIN = false;
    bf16_t* O; int ldc;
    __device__ __forceinline__ void operator()(const f32x4 (&acc)[2][2][4][2], const Unit& u, int wr, int wc, int fr, int fq) const {
        const int row0 = u.pm * BM + wr * 64 + fr, col0 = u.pn * BM + wc * 32 + 8 * fq;
#pragma unroll
        for (int ai = 0; ai < 2; ++ai)
#pragma unroll
            for (int m = 0; m < 4; ++m) { bf16_t* rowp = O + (size_t)(row0 + ai * HALF + m * 16) * ldc + col0;
#pragma unroll
                for (int bj = 0; bj < 2; ++bj) { const f32x4 v0 = acc[ai][bj][m][0], v1 = acc[ai][bj][m][1];
                    u32x4 w; w.x = cvt_pk_bf16(v0[0], v0[1]); w.y = cvt_pk_bf16(v0[2], v0[3]); w.z = cvt_pk_bf16(v1[0], v1[1]); w.w = cvt_pk_bf16(v1[2], v1[3]);
                    *(u32x4*)(rowp + bj * HALF) = w; } }
    }
};
struct EpiOdd {
    static constexpr bool PERM = true, AFTER_DRAIN = false;
    bf16_t* O; float* kp; float* vp; float* ks; float* vs;
    __device__ __forceinline__ void operator()(const f32x4 (&acc)[2][2][4][2], const Unit& u, int wr, int wc, int fr, int fq) const {
        const int row0 = u.pm * BM + wr * 64 + fr, colt = u.pn * BM, sect = colt >> 11, col0 = colt + wc * 32 + 8 * fq;
        float* pf = sect == 1 ? kp : vp; float* sf = sect == 1 ? ks : vs;
#pragma unroll
        for (int ai = 0; ai < 2; ++ai)
#pragma unroll
            for (int m = 0; m < 4; ++m) { const int row = row0 + ai * HALF + m * 16; bf16_t* rowp = O + (size_t)row * 8192 + col0;
#pragma unroll
                for (int bj = 0; bj < 2; ++bj) { f32x4 v0 = acc[ai][bj][m][0], v1 = acc[ai][bj][m][1];
                    if (sect == 3) {
#pragma unroll
                        for (int j = 0; j < 4; ++j) { v0[j] = v0[j] * __builtin_amdgcn_rcpf(1.f + __expf(-v0[j])); v1[j] = v1[j] * __builtin_amdgcn_rcpf(1.f + __expf(-v1[j])); } }
                    u32x4 w; w.x = cvt_pk_bf16(v0[0], v0[1]); w.y = cvt_pk_bf16(v0[2], v0[3]); w.z = cvt_pk_bf16(v1[0], v1[1]); w.w = cvt_pk_bf16(v1[2], v1[3]);
                    *(u32x4*)(rowp + bj * HALF) = w;
                    if (sect == 1 || sect == 2) { const int cc = col0 + bj * HALF - sect * 2048;
                        if (row < 16384) { float* d = pf + (size_t)row * 2048 + cc; *(f32x4*)d = v0; *(f32x4*)(d + 4) = v1; }
                        else if (row < 16512) { float* d = sf + (size_t)(row - 16384) * 2048 + cc; *(f32x4*)d = v0; *(f32x4*)(d + 4) = v1; } } } }
    }
};
struct EpiRes {
    static constexpr bool PERM = false, AFTER_DRAIN = false;
    const float* X; float* Y; float alpha;
    __device__ __forceinline__ void operator()(const f32x4 (&acc)[2][2][4][2], const Unit& u, int wr, int wc, int fr, int fq) const {
        const int row0 = u.pm * BM + wr * 64 + fr, col0 = u.pn * BM + wc * 32 + 4 * fq;
#pragma unroll
        for (int ai = 0; ai < 2; ++ai)
#pragma unroll
            for (int m = 0; m < 4; ++m) { const size_t off = (size_t)(row0 + ai * HALF + m * 16) * 1024 + col0;
#pragma unroll
                for (int bj = 0; bj < 2; ++bj)
#pragma unroll
                    for (int n = 0; n < 2; ++n) { const f32x4 xv = *(const f32x4*)(X + off + bj * HALF + n * 16); *(f32x4*)(Y + off + bj * HALF + n * 16) = acc[ai][bj][m][n] + xv * alpha; }
                asm volatile("" ::: "memory"); }
    }
};
template <class Epi, class Sched, bool ALIGN_EPI = false, bool SP2 = false>
__device__ __forceinline__ void gemm_phase(PG8_LAS unsigned char* lds, const Gemm g, const Sched& S, const Epi& E) {
    int tid_ = threadIdx.x; asm volatile("" : "+v"(tid_)); const int tid = tid_, wid = __builtin_amdgcn_readfirstlane(tid >> 6), lane = tid & 63, wr = wid >> 2, wc = wid & 3, fr = lane & 15, fq = lane >> 4;
    const int K = g.K, nt = K / BK;
    unsigned voffA[2], voffB[2];
#pragma unroll
    for (int i = 0; i < 2; ++i) { int R, C; stage_rc(tid * 16 + i * 8192, R, C); const int Rb = Epi::PERM ? ((R & ~31) + perm32(R & 31)) : R;
        voffA[i] = (unsigned)(R * K + C) * 2u; voffB[i] = (unsigned)(Rb * K + C) * 2u; }
    const size_t kstep = (size_t)(BK * 2);
    const size_t hstep = (size_t)HALF * K * 2;
    const size_t tstep = 2 * hstep;
    const unsigned ldsw = (unsigned)wid * 1024u;
    const int aoff = lds_byte(wr * 64 + fr, fq * 8), boff = lds_byte(wc * 32 + fr, fq * 8);
#define PG8_SA(b, h) (((b) * 2 + (h)) * HTB)
#define PG8_SB(b, h) ((4 + (b) * 2 + (h)) * HTB)
#define PG8_STAGE(bufoff, gbase, voff) do { _Pragma("unroll") for (int _i = 0; _i < 2; ++_i) \
        __builtin_amdgcn_global_load_lds((const unsigned*)((const char*)(gbase) + (voff)[_i]), (PG8_LAS unsigned*)(lds + (bufoff) + ldsw + _i * 8192), 16, 0, 0); } while (0)
#define PG8_LDA(dst, b, h) do { _Pragma("unroll") for (int m = 0; m < 4; ++m) _Pragma("unroll") for (int k = 0; k < 2; ++k) dst[m][k] = *(const PG8_LAS bf16x8*)(lds + PG8_SA(b, h) + aoff + m * 2048 + k * 1024); } while (0)
#define PG8_LDB(dst, b, h) do { _Pragma("unroll") for (int n = 0; n < 2; ++n) _Pragma("unroll") for (int k = 0; k < 2; ++k) dst[n][k] = *(const PG8_LAS bf16x8*)(lds + PG8_SB(b, h) + boff + n * 2048 + k * 1024); } while (0)
#define PG8_MMA(ai, bj, At, Bt) do { __builtin_amdgcn_s_setprio(1); _Pragma("unroll") for (int m = 0; m < 4; ++m) _Pragma("unroll") for (int n = 0; n < 2; ++n) _Pragma("unroll") for (int k = 0; k < 2; ++k) \
        acc[ai][bj][m][n] = __builtin_amdgcn_mfma_f32_16x16x32_bf16(Bt[n][k], At[m][k], acc[ai][bj][m][n], 0, 0, 0); __builtin_amdgcn_s_setprio(0); } while (0)
#define PG8_WAIT_V(n) asm volatile("s_waitcnt vmcnt(" #n ")" ::: "memory")
#define PG8_WAIT_L(n) asm volatile("s_waitcnt lgkmcnt(" #n ")" ::: "memory")
#define PG8_BAR __builtin_amdgcn_s_barrier()
#define PG8_SCHED __builtin_amdgcn_sched_barrier(0)
    Unit cur, nxt; int ui = 0;
    if (!S.next(0, cur)) return;
    f32x4 acc[2][2][4][2];
#pragma unroll
    for (int a = 0; a < 2; ++a)
#pragma unroll
        for (int b = 0; b < 2; ++b)
#pragma unroll
            for (int m = 0; m < 4; ++m)
#pragma unroll
                for (int n = 0; n < 2; ++n) acc[a][b][m][n] = (f32x4){0.f, 0.f, 0.f, 0.f};
    bf16x8 At[4][2], B0[2][2], B1[2][2];
    const char* cA = (const char*)g.A + (size_t)cur.pm * tstep; const char* cB = (const char*)g.Bt + (size_t)cur.pn * tstep;
    S.a_ready(cur);
    if constexpr (SP2) {
        PG8_STAGE(PG8_SB(0, 0), cB, voffB); PG8_STAGE(PG8_SB(0, 1), cB + hstep, voffB); PG8_STAGE(PG8_SA(0, 0), cA, voffA); PG8_STAGE(PG8_SA(0, 1), cA + hstep, voffA);
        if (wr == 1) PG8_BAR;
        PG8_WAIT_V(2); PG8_BAR;
        PG8_STAGE(PG8_SB(1, 0), cB + kstep, voffB); PG8_STAGE(PG8_SA(1, 0), cA + kstep, voffA); PG8_STAGE(PG8_SB(1, 1), cB + hstep + kstep, voffB);
        PG8_WAIT_V(6); PG8_BAR;
    } else {
        PG8_STAGE(PG8_SB(0, 0), cB, voffB); PG8_STAGE(PG8_SA(0, 0), cA, voffA); PG8_STAGE(PG8_SB(0, 1), cB + hstep, voffB); PG8_STAGE(PG8_SA(0, 1), cA + hstep, voffA);
        if (wr == 1) PG8_BAR;
        PG8_WAIT_V(4); PG8_BAR;
        PG8_STAGE(PG8_SB(1, 0), cB + kstep, voffB); PG8_STAGE(PG8_SA(1, 0), cA + kstep, voffA); PG8_STAGE(PG8_SB(1, 1), cB + hstep + kstep, voffB);
        PG8_WAIT_V(6); PG8_BAR;
    }
    for (;;) {
        const bool has_next = S.next(ui + 1, nxt);
        const char* nA = has_next ? (const char*)g.A + (size_t)nxt.pm * tstep : cA; const char* nB = has_next ? (const char*)g.Bt + (size_t)nxt.pn * tstep : cB;
        for (int t = 0; t < nt; t += 2) {
            const bool last = (t == nt - 2);
            const char* a1 = cA + (size_t)(t + 1) * kstep;
            const char* a2 = last ? nA : cA + (size_t)(t + 2) * kstep; const char* b2 = last ? nB : cB + (size_t)(t + 2) * kstep;
            const char* a3 = a2 + kstep; const char* b3 = b2 + kstep;
            if (last && has_next) S.a_ready(nxt);
            if constexpr (SP2) {
            PG8_LDB(B0, 0, 0); PG8_LDB(B1, 0, 1); PG8_SCHED; PG8_LDA(At, 0, 0); PG8_STAGE(PG8_SA(1, 1), a1 + hstep, voffA);
            PG8_WAIT_V(8); PG8_WAIT_L(0); PG8_BAR; PG8_MMA(0, 0, At, B0); PG8_MMA(0, 1, At, B1); PG8_BAR; PG8_SCHED;
            PG8_LDA(At, 0, 1); PG8_STAGE(PG8_SB(0, 0), b2, voffB); PG8_STAGE(PG8_SB(0, 1), b2 + hstep, voffB); PG8_STAGE(PG8_SA(0, 0), a2, voffA);
            PG8_WAIT_V(8); PG8_WAIT_L(0); PG8_BAR; PG8_MMA(1, 0, At, B0); PG8_MMA(1, 1, At, B1); PG8_BAR; PG8_SCHED;
            PG8_LDB(B0, 1, 0); PG8_LDB(B1, 1, 1); PG8_SCHED; PG8_LDA(At, 1, 0); PG8_STAGE(PG8_SA(0, 1), a2 + hstep, voffA);
            PG8_WAIT_V(8); PG8_WAIT_L(0); PG8_BAR; PG8_MMA(0, 0, At, B0); PG8_MMA(0, 1, At, B1); PG8_BAR; PG8_SCHED;
            PG8_LDA(At, 1, 1); PG8_STAGE(PG8_SB(1, 0), b3, voffB); PG8_STAGE(PG8_SB(1, 1), b3 + hstep, voffB); PG8_STAGE(PG8_SA(1, 0), a3, voffA);
            PG8_WAIT_V(8); PG8_WAIT_L(0); PG8_BAR; PG8_MMA(1, 0, At, B0); PG8_MMA(1, 1, At, B1); PG8_BAR; PG8_SCHED;
            } else {
            PG8_LDB(B0, 0, 0); PG8_SCHED; PG8_LDA(At, 0, 0); PG8_STAGE(PG8_SA(1, 1), a1 + hstep, voffA);
            PG8_WAIT_L(8); PG8_BAR; PG8_WAIT_L(0); PG8_MMA(0, 0, At, B0); PG8_BAR; PG8_SCHED;
            PG8_LDB(B1, 0, 1); PG8_STAGE(PG8_SB(0, 0), b2, voffB);
            PG8_BAR; PG8_WAIT_L(0); PG8_MMA(0, 1, At, B1); PG8_BAR;
            PG8_LDA(At, 0, 1); PG8_STAGE(PG8_SA(0, 0), a2, voffA);
            PG8_BAR; PG8_WAIT_L(0); PG8_MMA(1, 0, At, B0); PG8_BAR; PG8_SCHED;
            PG8_STAGE(PG8_SB(0, 1), b2 + hstep, voffB);
            PG8_WAIT_V(6); PG8_BAR; PG8_MMA(1, 1, At, B1); PG8_BAR;
            PG8_LDB(B0, 1, 0); PG8_SCHED; PG8_LDA(At, 1, 0); PG8_STAGE(PG8_SA(0, 1), a2 + hstep, voffA);
            PG8_WAIT_L(8); PG8_BAR; PG8_WAIT_L(0); PG8_MMA(0, 0, At, B0); PG8_BAR; PG8_SCHED;
            PG8_LDB(B1, 1, 1); PG8_STAGE(PG8_SB(1, 0), b3, voffB);
            PG8_BAR; PG8_WAIT_L(0); PG8_MMA(0, 1, At, B1); PG8_BAR;
            PG8_LDA(At, 1, 1); PG8_STAGE(PG8_SA(1, 0), a3, voffA);
            PG8_BAR; PG8_WAIT_L(0); PG8_MMA(1, 0, At, B0); PG8_BAR; PG8_SCHED;
            PG8_STAGE(PG8_SB(1, 1), b3 + hstep, voffB);
            PG8_WAIT_V(6); PG8_BAR; PG8_MMA(1, 1, At, B1); PG8_BAR;
            }
        }
        if constexpr (ALIGN_EPI) { if (wr == 0) PG8_BAR; }
        if constexpr (!Epi::AFTER_DRAIN) { E(acc, cur, wr, wc, fr, fq); S.done(cur); }
        if (!has_next) break;
#pragma unroll
        for (int a = 0; a < 2; ++a)
#pragma unroll
            for (int b = 0; b < 2; ++b)
#pragma unroll
                for (int m = 0; m < 4; ++m)
#pragma unroll
                    for (int n = 0; n < 2; ++n) acc[a][b][m][n] = (f32x4){0.f, 0.f, 0.f, 0.f};
        cur = nxt; cA = nA; cB = nB; ++ui;
        if constexpr (ALIGN_EPI) { if (wr == 1) PG8_BAR; }
    }
    PG8_WAIT_V(0);
    if constexpr (!ALIGN_EPI) { if (wr == 0) PG8_BAR; }
    PG8_BAR;
    if constexpr (Epi::AFTER_DRAIN) { E.fused(acc, cur, wr, wc, fr, fq, lds, wid, lane); S.done(cur); }
#undef PG8_SA
#undef PG8_SB
#undef PG8_STAGE
#undef PG8_LDA
#undef PG8_LDB
#undef PG8_MMA
#undef PG8_WAIT_V
#undef PG8_WAIT_L
#undef PG8_BAR
#undef PG8_SCHED
}
}
#define GAS __attribute__((address_space(1)))
#define LAS __attribute__((address_space(3)))
typedef unsigned short bf16;
typedef unsigned v4u __attribute__((ext_vector_type(4)));
typedef float f32x4 __attribute__((ext_vector_type(4)));
typedef short bf16x8 __attribute__((ext_vector_type(8)));
typedef GAS unsigned gu32;
typedef GAS unsigned long long gu64;
#define RLX_AGENT __ATOMIC_RELAXED, __HIP_MEMORY_SCOPE_AGENT
#define LDS_WAIT() asm volatile("s_waitcnt lgkmcnt(0)" ::: "memory")
#define VM_WAIT() asm volatile("s_waitcnt vmcnt(0)" ::: "memory")
__device__ __forceinline__ unsigned long long rt() { return __builtin_amdgcn_s_memrealtime(); }
__device__ __forceinline__ unsigned f2bf(float f) { unsigned u = __builtin_bit_cast(unsigned, f); return (u + 0x7fffu + ((u >> 16) & 1u)) >> 16; }
__device__ __forceinline__ unsigned pk2(float lo, float hi) { return f2bf(lo) | (f2bf(hi) << 16); }

#define XB_TMO      128
#define XB_XCNT(j)  (256  + 64 * (j))
#define XB_XSUB(j)  (1280 + 64 * (j))
#define XB_XGEN(j)  (2304 + 64 * (j))
#define XB_TOP      3328
#define XB_TOPGEN   3392
#define XCD_BAR_WORDS 3456
#define XB_SPIN_CAP (1u << 24)

__device__ __forceinline__ unsigned xb_ld(unsigned* p)              { return __hip_atomic_load(p, __ATOMIC_RELAXED, __HIP_MEMORY_SCOPE_AGENT); }
__device__ __forceinline__ unsigned xb_add(unsigned* p, unsigned v) { return __hip_atomic_fetch_add(p, v, __ATOMIC_RELAXED, __HIP_MEMORY_SCOPE_AGENT); }
__device__ __forceinline__ unsigned xb_xcc_id() { return (unsigned)__builtin_amdgcn_s_getreg((3 << 11) | 20) & 0xFu; }
#define XB_SPIN(cond, bar) do { unsigned _sp = 0; while (cond) { __builtin_amdgcn_s_sleep(1); \
    if ((++_sp & 255u) == 0u) { if (xb_ld(&(bar)[XB_TMO])) break; if (_sp > XB_SPIN_CAP) { atomicAdd(&(bar)[XB_TMO], 1u); break; } } } } while (0)

struct XcdBarrier {
    unsigned* bar; unsigned x;
    volatile LAS unsigned* st;
};

__device__ __forceinline__ XcdBarrier xcd_barrier_post(unsigned* bar, volatile LAS unsigned* st) {
    XcdBarrier b; b.bar = bar; b.x = xb_xcc_id(); b.st = st;
    if (threadIdx.x == 0) (void)xb_add(&bar[XB_XCNT(b.x)], 1u);
    return b;
}
__device__ __forceinline__ void xcd_barrier_complete(unsigned* bar, unsigned x, unsigned& nloc, unsigned& nx) {
    const unsigned G = gridDim.x * gridDim.y * gridDim.z;
    unsigned sum, cnt, mine, sp = 0u;
    for (;;) {
        sum = 0u; cnt = 0u; mine = 0u;
#pragma unroll
        for (unsigned j = 0; j < 16; ++j) { const unsigned c = xb_ld(&bar[XB_XCNT(j)]); sum += c; cnt += (c > 0u) ? 1u : 0u; mine = (j == x) ? c : mine; }
        if (sum == G) break;
        __builtin_amdgcn_s_sleep(1);
        if ((++sp & 255u) == 0u) { if (xb_ld(&bar[XB_TMO])) break; if (sp > XB_SPIN_CAP) { atomicAdd(&bar[XB_TMO], 1u); break; } }
    }
    nloc = mine > 0u ? mine : 1u; nx = cnt > 0u ? cnt : 1u;
}

__device__ __forceinline__ void xcd_barrier(const XcdBarrier& b) {
    asm volatile("s_waitcnt vmcnt(0)" ::: "memory");
    __syncthreads();
    if (threadIdx.x == 0) {
        unsigned* bar = b.bar; unsigned bx_ = b.x; asm volatile("" : "+s"(bx_), "+s"(bar));
        __builtin_amdgcn_s_waitcnt(0);
        unsigned nloc = b.st[0], nx = b.st[1];
        if (nloc == 0u) { xcd_barrier_complete(bar, bx_, nloc, nx); b.st[0] = nloc; b.st[1] = nx; }
        const unsigned old = xb_add(&bar[XB_XSUB(bx_)], 1u);
        const unsigned gen = old / nloc;
        if (old + 1u == (gen + 1u) * nloc) {
            __builtin_amdgcn_fence(__ATOMIC_RELEASE, "agent");
            asm volatile("s_waitcnt vmcnt(0)" ::: "memory");
            const unsigned og = xb_add(&bar[XB_TOP], 1u);
            const unsigned tg = og / nx;
            if (og + 1u == (tg + 1u) * nx) xb_add(&bar[XB_TOPGEN], 1u);
            else XB_SPIN(xb_ld(&bar[XB_TOPGEN]) == tg, bar);
            __builtin_amdgcn_fence(__ATOMIC_ACQUIRE, "agent");
            xb_add(&bar[XB_XGEN(bx_)], 1u);
            asm volatile("s_waitcnt vmcnt(0)" ::: "memory");
        } else {
            XB_SPIN(xb_ld(&bar[XB_XGEN(bx_)]) == gen, bar);
            __builtin_amdgcn_fence(__ATOMIC_ACQUIRE, "agent");
            asm volatile("s_waitcnt vmcnt(0)" ::: "memory");
        }
    }
    __syncthreads();
}
constexpr int NWAVES = 8;
constexpr int DM = 1024, NB = 4, SEQ = 4096, SB = 8, SSEQ = 16, PAST = 4096;
constexpr int MP = NB * SEQ, MS = SB * SSEQ, MTOK = MP + MS, MPAD = 16640;
constexpr int IN_EVEN = 7168, IN_ODD = 8192;
constexpr int NCHUNK = 256 + 8;
constexpr float LN_EPS = 1e-5f;
constexpr float ALPHA_RES = 1.6817928305074290f;
constexpr size_t OY_P = 0, OY_S = 16777216, OCONV_P = 16908288, OHGRN_P = 17154048, OK_P = 18202624, OV_P = 85311488, OCONV_S = 152420352, OHGRN_S = 152911872, OK_S = 155009024, OV_S = 155533312, OUT_TOTAL = 156057600;
constexpr size_t MiB = 1u << 20;
constexpr size_t WS_CTL = 0, CTL_ZERO_BYTES = 1 * MiB;
constexpr size_t WS_WIE = 2 * MiB, WS_WOE = 30 * MiB, WS_WIO = 38 * MiB, WS_WOO = 70 * MiB;
constexpr size_t WS_XB = 80 * MiB, WS_X = 114 * MiB, WS_Y = 180 * MiB, WS_AO = 246 * MiB, WS_H = 312 * MiB;
constexpr size_t WS_QH = 572 * MiB, WS_KT = 606 * MiB, WS_VT = 640 * MiB, WS_OI = 674 * MiB, WS_OX = 708 * MiB, WS_DD = 742 * MiB, WS_PART = 744 * MiB, WS_END = 768 * MiB;
constexpr int CW_BAR = 4096;
constexpr int LDS_BYTES = 147456;
constexpr int MISC_OFF = 146432;

struct Frame {
    LAS unsigned char* lds;
    volatile LAS unsigned* MISC;
    int tid, lane, wave, vcu, G;
    float* out; unsigned char* ws;
};
struct Args { const float* in[23]; float* out; unsigned char* ws; };
__device__ __forceinline__ float bf2f(unsigned short b) { return __uint_as_float(((unsigned)b) << 16); }
__device__ __forceinline__ float bflo(unsigned w) { return __uint_as_float(w << 16); }
__device__ __forceinline__ float bfhi(unsigned w) { return __uint_as_float(w & 0xffff0000u); }
__device__ __forceinline__ unsigned cvtpk(float lo, float hi) { unsigned r; asm volatile("v_cvt_pk_bf16_f32 %0, %1, %2" : "=v"(r) : "v"(lo), "v"(hi)); return r; }
__device__ __forceinline__ float sigmoidf_(float x) { return __builtin_amdgcn_rcpf(1.f + __expf(-x)); }
__device__ __forceinline__ float siluf_(float x) { return x * sigmoidf_(x); }
__device__ __forceinline__ float wave_sum(float v) {
#pragma unroll
    for (int o = 1; o < 64; o <<= 1) v += __shfl_xor(v, o);
    return v;
}
#define WG_BAR() do { asm volatile("s_waitcnt vmcnt(0) lgkmcnt(0)" ::: "memory"); __builtin_amdgcn_s_barrier(); asm volatile("" ::: "memory"); } while (0)
#define LDS_BAR() do { asm volatile("s_waitcnt lgkmcnt(0)" ::: "memory"); __builtin_amdgcn_s_barrier(); asm volatile("" ::: "memory"); } while (0)

__device__ __forceinline__ void p0_transpose_item(const float* W, int K, int N, bf16* WT, LAS float* scr, int item, int lane) {
    const int nblk = N / 32, kb = item / nblk, nb = item % nblk, k0 = 64 * kb, n0 = 32 * nb;
#pragma unroll 8
    for (int i = 0; i < 32; ++i) { const int kk = 2 * i + (lane >> 5); scr[kk * 33 + (lane & 31)] = W[(size_t)(k0 + kk) * N + n0 + (lane & 31)]; }
    LDS_WAIT(); asm volatile("" ::: "memory");
    const int c = lane & 7;
#pragma unroll
    for (int j = 0; j < 4; ++j) { const int n = (lane >> 3) + 8 * j; const LAS float* s = scr + (8 * c) * 33 + n;
        v4u o; o.x = pk2(s[0 * 33], s[1 * 33]); o.y = pk2(s[2 * 33], s[3 * 33]); o.z = pk2(s[4 * 33], s[5 * 33]); o.w = pk2(s[6 * 33], s[7 * 33]);
        *(GAS v4u*)(WT + (size_t)(n0 + n) * K + k0 + 8 * c) = o; }
    LDS_WAIT(); asm volatile("" ::: "memory");
}
__device__ __forceinline__ void p0_prologue(const Frame& F0, const Args& A) {
    Frame F = F0; asm volatile("" : "+v"(F.tid)); asm volatile("" : "+s"(F.vcu)); F.lane = F.tid & 63; F.wave = __builtin_amdgcn_readfirstlane(F.tid >> 6);
    LAS float* scr = (LAS float*)(F.lds + F.wave * 16384);
    const int gw = F.vcu * NWAVES + F.wave, NGW = F.G * NWAVES;
    constexpr int I_IE = (DM / 64) * (IN_EVEN / 32), I_OE = (2048 / 64) * (DM / 32), I_IO = (DM / 64) * (IN_ODD / 32), I_OO = I_OE;
    constexpr int PER = I_IE + I_OE + I_IO + I_OO;
    for (int it = gw; it < 2 * PER; it += NGW) {
        const int l = it / PER; int r = it - l * PER;
        if (r < I_IE) { p0_transpose_item(A.in[6] + (size_t)l * DM * IN_EVEN, DM, IN_EVEN, (bf16*)(F.ws + WS_WIE) + (size_t)l * IN_EVEN * DM, scr, r, F.lane); continue; } r -= I_IE;
        if (r < I_OE) { p0_transpose_item(A.in[7] + (size_t)l * 2048 * DM, 2048, DM, (bf16*)(F.ws + WS_WOE) + (size_t)l * DM * 2048, scr, r, F.lane); continue; } r -= I_OE;
        if (r < I_IO) { p0_transpose_item(A.in[14] + (size_t)l * DM * IN_ODD, DM, IN_ODD, (bf16*)(F.ws + WS_WIO) + (size_t)l * IN_ODD * DM, scr, r, F.lane); continue; } r -= I_IO;
        p0_transpose_item(A.in[15] + (size_t)l * 2048 * DM, 2048, DM, (bf16*)(F.ws + WS_WOO) + (size_t)l * DM * 2048, scr, r, F.lane);
    }
    float* X = (float*)(F.ws + WS_X); bf16* XB = (bf16*)(F.ws + WS_XB); bf16* AO = (bf16*)(F.ws + WS_AO);
    for (int m = gw; m < MPAD; m += NGW) {
        GAS unsigned long long* o8 = (GAS unsigned long long*)(XB + (size_t)m * DM) + F.lane;
        if (m < MTOK) {
            const float* src = m < MP ? A.in[0] + (size_t)m * DM : A.in[1] + (size_t)(m - MP) * DM;
            const GAS f32x4* xr = (const GAS f32x4*)src + F.lane; GAS f32x4* xo = (GAS f32x4*)(X + (size_t)m * DM) + F.lane;
#pragma unroll
            for (int j = 0; j < 4; ++j) { const f32x4 v = xr[64 * j]; xo[64 * j] = v; o8[64 * j] = (unsigned long long)pk2(v.x, v.y) | ((unsigned long long)pk2(v.z, v.w) << 32); }
        } else {
#pragma unroll
            for (int j = 0; j < 4; ++j) o8[64 * j] = 0ull;
            GAS v4u* a = (GAS v4u*)(AO + (size_t)m * 2048) + F.lane;
#pragma unroll
            for (int j = 0; j < 4; ++j) a[64 * j] = (v4u){0u, 0u, 0u, 0u};
        }
    }
}
__device__ __forceinline__ void ln_phase(const Frame& F0, const Args& A, int layer, bool last) {
    Frame F = F0; asm volatile("" : "+v"(F.tid)); asm volatile("" : "+s"(F.vcu)); F.lane = F.tid & 63; F.wave = __builtin_amdgcn_readfirstlane(F.tid >> 6);
    const int gw = F.vcu * NWAVES + F.wave, NGW = F.G * NWAVES;
    const float* Y = (const float*)(F.ws + WS_Y); float* X = (float*)(F.ws + WS_X); bf16* XB = (bf16*)(F.ws + WS_XB);
    const GAS f32x4* gp = (const GAS f32x4*)(A.in[21] + (size_t)layer * DM) + F.lane; const GAS f32x4* bp = (const GAS f32x4*)(A.in[22] + (size_t)layer * DM) + F.lane;
    f32x4 g[4], bb[4];
#pragma unroll
    for (int j = 0; j < 4; ++j) { g[j] = gp[64 * j]; bb[j] = bp[64 * j]; }
    for (int m = gw; m < MTOK; m += NGW) {
        const GAS f32x4* yr = (const GAS f32x4*)(Y + (size_t)m * DM) + F.lane;
        f32x4 v[4]; float s = 0.f;
#pragma unroll
        for (int j = 0; j < 4; ++j) { v[j] = yr[64 * j]; s += (v[j].x + v[j].y) + (v[j].z + v[j].w); }
        const float mean = wave_sum(s) * (1.f / DM); float s2 = 0.f;
#pragma unroll
        for (int j = 0; j < 4; ++j) { v[j] = v[j] - mean; s2 += (v[j].x * v[j].x + v[j].y * v[j].y) + (v[j].z * v[j].z + v[j].w * v[j].w); }
        const float rstd = 1.f / sqrtf(wave_sum(s2) * (1.f / DM) + LN_EPS);
        float* dst = last ? (m < MP ? F.out + OY_P + (size_t)m * DM : F.out + OY_S + (size_t)(m - MP) * DM) : X + (size_t)m * DM;
        GAS f32x4* xo = (GAS f32x4*)dst + F.lane; GAS unsigned long long* o8 = (GAS unsigned long long*)(XB + (size_t)m * DM) + F.lane;
#pragma unroll
        for (int j = 0; j < 4; ++j) { const f32x4 o = v[j] * rstd * g[j] + bb[j]; xo[64 * j] = o; if (!last) o8[64 * j] = (unsigned long long)pk2(o.x, o.y) | ((unsigned long long)pk2(o.z, o.w) << 32); }
    }
}
__device__ __forceinline__ void conv_phase(const Frame& F0, const Args& A, int e) {
    Frame F = F0; asm volatile("" : "+v"(F.tid)); asm volatile("" : "+s"(F.vcu)); F.lane = F.tid & 63; F.wave = __builtin_amdgcn_readfirstlane(F.tid >> 6);
    const bf16* H = (const bf16*)(F.ws + WS_H); bf16* AO = (bf16*)(F.ws + WS_AO);
    LAS unsigned* ub = (LAS unsigned*)F.lds;
    LAS float* red = (LAS float*)(F.lds + 62 * 512 * 4);
    const int tid = F.tid, ch = 2 * tid;
    typedef float f32x2 __attribute__((ext_vector_type(2)));
    const float* cw = A.in[8] + (size_t)e * 31 * DM; f32x2 w[31];
#pragma unroll
    for (int j = 0; j < 31; ++j) w[j] = *(const GAS f32x2*)(cw + (size_t)j * DM + ch);
    const f32x2 cb = *(const GAS f32x2*)(A.in[9] + (size_t)e * DM + ch), lg = *(const GAS f32x2*)(A.in[10] + (size_t)e * DM + ch), lb = *(const GAS f32x2*)(A.in[11] + (size_t)e * DM + ch);
    for (int unit = F.vcu; unit < 520; unit += F.G) {
        const bool samp = unit >= 512; const int b = samp ? unit - 512 : unit >> 7, t0 = samp ? 0 : (unit & 127) * 32;
        const size_t grow0 = samp ? (size_t)MP + b * SSEQ : (size_t)b * SEQ;
        const int T = samp ? SSEQ : SEQ;
        for (int j = 0; j < 62; ++j) {
            const int t = t0 - 30 + j; float u0 = 0.f, u1 = 0.f;
            if (t >= 0 && t < T) {
                const bf16* hp = H + (grow0 + t) * IN_EVEN; const unsigned a = *(const GAS unsigned*)(hp + ch), ga = *(const GAS unsigned*)(hp + 1024 + ch);
                u0 = bflo(a) * sigmoidf_(bflo(ga)); u1 = bfhi(a) * sigmoidf_(bfhi(ga));
                if (!samp && t >= SEQ - 30) *(GAS f32x2*)(F.out + OCONV_P + ((size_t)(e * NB + b) * 30 + (t - (SEQ - 30))) * DM + ch) = (f32x2){u0, u1};
                if (samp) *(GAS f32x2*)(F.out + OCONV_S + ((size_t)(e * SB + b) * 30 + (14 + t)) * DM + ch) = (f32x2){u0, u1};
            } else if (samp && t < 0) {
                const f32x2 s = *(const GAS f32x2*)(A.in[2] + ((size_t)(e * SB + b) * 30 + (30 + t)) * DM + ch); u0 = s.x; u1 = s.y;
                if (30 + t >= 16) *(GAS f32x2*)(F.out + OCONV_S + ((size_t)(e * SB + b) * 30 + (30 + t - 16)) * DM + ch) = s;
            }
            ub[j * 512 + tid] = cvtpk(u0, u1);
        }
        LDS_BAR();
        const int ngrp = samp ? 4 : 8;
        for (int tg = 0; tg < ngrp; ++tg) {
            f32x2 acc[4];
#pragma unroll
            for (int tt = 0; tt < 4; ++tt) acc[tt] = cb;
#pragma unroll
            for (int jj = 0; jj < 34; ++jj) { const unsigned pv = ub[(4 * tg + jj) * 512 + tid]; const f32x2 val = {bflo(pv), bfhi(pv)};
#pragma unroll
                for (int tt = 0; tt < 4; ++tt) { if (jj - tt >= 0 && jj - tt <= 30) acc[tt] += w[jj - tt] * val; } }
            float st[8];
#pragma unroll
            for (int tt = 0; tt < 4; ++tt) { st[2 * tt] = acc[tt].x + acc[tt].y; st[2 * tt + 1] = acc[tt].x * acc[tt].x + acc[tt].y * acc[tt].y; }
#pragma unroll
            for (int i = 0; i < 8; ++i) st[i] = wave_sum(st[i]);
            LAS float* rb = red + (tg & 1) * 64;
            if (F.lane < 8) { float v = st[0];
#pragma unroll
                for (int i = 1; i < 8; ++i) v = (F.lane == i) ? st[i] : v;
                rb[F.wave * 8 + F.lane] = v; }
            LDS_BAR();
#pragma unroll
            for (int tt = 0; tt < 4; ++tt) {
                float s1 = 0.f, s2 = 0.f;
#pragma unroll
                for (int wv = 0; wv < 8; ++wv) { s1 += rb[wv * 8 + 2 * tt]; s2 += rb[wv * 8 + 2 * tt + 1]; }
                const float mean = s1 * (1.f / DM), var = fmaxf(s2 * (1.f / DM) - mean * mean, 0.f), rstd = 1.f / sqrtf(var + LN_EPS);
                const int t = t0 + 4 * tg + tt; const size_t row = grow0 + t;
                const unsigned zz = *(const GAS unsigned*)(H + row * IN_EVEN + 2048 + ch);
                const float c0 = (acc[tt].x - mean) * rstd * lg.x + lb.x, c1 = (acc[tt].y - mean) * rstd * lg.y + lb.y;
                *(GAS unsigned*)(AO + row * 2048 + ch) = cvtpk(siluf_(c0) * siluf_(bflo(zz)), siluf_(c1) * siluf_(bfhi(zz)));
            }
        }
        LDS_BAR();
    }
}
__device__ __forceinline__ void hgrn_prep_phase(const Frame& F0, const Args& A, int e) {
    Frame F = F0; asm volatile("" : "+v"(F.tid)); asm volatile("" : "+s"(F.vcu)); F.lane = F.tid & 63; F.wave = __builtin_amdgcn_readfirstlane(F.tid >> 6);
    const bf16* H = (const bf16*)(F.ws + WS_H);
    bf16* QH = (bf16*)(F.ws + WS_QH); bf16* KT = (bf16*)(F.ws + WS_KT); bf16* VT = (bf16*)(F.ws + WS_VT); bf16* OI = (bf16*)(F.ws + WS_OI); float* DD = (float*)(F.ws + WS_DD);
    LAS bf16* Qt = (LAS bf16*)F.lds;
    LAS bf16* Kt = Qt + 64 * 136;
    LAS bf16* Vt = Kt + 64 * 136;
    LAS bf16* At = Vt + 128 * 72;
    LAS float* tot = (LAS float*)(At + 64 * 72);
    const int tid = F.tid, k = tid & 127, rg = tid >> 7, lane = F.lane, w = F.wave, fr = lane & 15, g = lane >> 4;
    for (int unit = F.vcu; unit < NCHUNK * 8; unit += F.G) {
        const int cid = unit >> 3, h = unit & 7; const bool samp = cid >= 256; const int L = samp ? SSEQ : 64;
        const size_t grow0 = samp ? (size_t)MP + (cid - 256) * SSEQ : (size_t)cid * 64;
        const int chn = h * 128 + k;
        float lbv = 0.f; if (e == 1) lbv = sigmoidf_(A.in[12][DM + chn] - A.in[12][chn]);
        float qq[16], gg[16], kk[16], vv[16];
#pragma unroll
        for (int r = 0; r < 16; ++r) { const int row = rg * 16 + r; qq[r] = 0.f; gg[r] = 0.f; kk[r] = 0.f; vv[r] = 0.f;
            if (row < L) { const bf16* hp = H + (grow0 + row) * IN_EVEN + chn;
                const float q = bf2f(hp[3072]), fr_ = bf2f(hp[4096]); vv[r] = bf2f(hp[5120]);
                const float sg = sigmoidf_(fr_), f = lbv + (1.f - lbv) * sg;
                gg[r] = (lbv > 0.f) ? __logf(f) : -(fmaxf(-fr_, 0.f) + log1pf(__expf(-fabsf(fr_))));
                kk[r] = (1.f - lbv) * sigmoidf_(-fr_); qq[r] = siluf_(q); } }
        float run = 0.f;
#pragma unroll
        for (int r = 0; r < 16; ++r) { run += gg[r]; gg[r] = run; }
        tot[rg * 128 + k] = run;
        LDS_BAR();
        const float t0 = tot[k], t1 = tot[128 + k], t2 = tot[256 + k], t3 = tot[384 + k];
        const float off = (rg > 0 ? t0 : 0.f) + (rg > 1 ? t1 : 0.f) + (rg > 2 ? t2 : 0.f), bm = t0 + t1, blast = (t0 + t1) + (t2 + t3);
        unsigned kw[8], vw[8];
#pragma unroll
        for (int r = 0; r < 16; r += 2) {
            float khv[2];
#pragma unroll
            for (int i = 0; i < 2; ++i) { const int rr = r + i, row = rg * 16 + rr; const float b = off + gg[rr];
                const float qt = qq[rr] * __expf(fminf(b - bm, 80.f)), kt = kk[rr] * __expf(fminf(bm - b, 80.f));
                Qt[row * 136 + k] = (bf16)f2bf(qt); Kt[row * 136 + k] = (bf16)f2bf(kt);
                QH[((size_t)cid * 64 + row) * DM + chn] = (bf16)f2bf(qq[rr] * __expf(b));
                khv[i] = kk[rr] * __expf(blast - b); }
            kw[r >> 1] = pk2(khv[0], khv[1]); vw[r >> 1] = pk2(vv[r], vv[r + 1]);
        }
        { GAS v4u* kd = (GAS v4u*)(KT + (((size_t)cid * 8 + h) * 128 + k) * 64 + rg * 16); kd[0] = (v4u){kw[0], kw[1], kw[2], kw[3]}; kd[1] = (v4u){kw[4], kw[5], kw[6], kw[7]};
          GAS v4u* vd = (GAS v4u*)(VT + (((size_t)cid * 8 + h) * 128 + k) * 64 + rg * 16); vd[0] = (v4u){vw[0], vw[1], vw[2], vw[3]}; vd[1] = (v4u){vw[4], vw[5], vw[6], vw[7]};
          LAS v4u* vl = (LAS v4u*)(Vt + k * 72 + rg * 16); vl[0] = (v4u){vw[0], vw[1], vw[2], vw[3]}; vl[1] = (v4u){vw[4], vw[5], vw[6], vw[7]};
          if (rg == 0) DD[((size_t)cid * 8 + h) * 128 + k] = __expf(blast); }
        LDS_BAR();
        { const int mt = w & 3;
#pragma unroll
          for (int n2 = 0; n2 < 2; ++n2) { const int nt = 2 * (w >> 2) + n2; f32x4 acc = {0.f, 0.f, 0.f, 0.f};
              if (nt <= mt) {
#pragma unroll
                  for (int ks = 0; ks < 4; ++ks) { const bf16x8 a = *(const LAS bf16x8*)(Qt + (16 * mt + fr) * 136 + 32 * ks + 8 * g), bq = *(const LAS bf16x8*)(Kt + (16 * nt + fr) * 136 + 32 * ks + 8 * g);
                      acc = __builtin_amdgcn_mfma_f32_16x16x32_bf16(a, bq, acc, 0, 0, 0); } }
              const int s = 16 * nt + fr;
#pragma unroll
              for (int r = 0; r < 4; ++r) { const int t = 16 * mt + 4 * g + r; At[t * 72 + s] = (bf16)f2bf(s <= t ? acc[r] : 0.f); } } }
        LDS_BAR();
        { const int mt = w & 3; bf16x8 bt[2];
#pragma unroll
          for (int ks = 0; ks < 2; ++ks) bt[ks] = *(const LAS bf16x8*)(At + (16 * mt + fr) * 72 + 32 * ks + 8 * g);
#pragma unroll
          for (int v4 = 0; v4 < 4; ++v4) { const int vt = 4 * (w >> 2) + v4; f32x4 acc = {0.f, 0.f, 0.f, 0.f};
#pragma unroll
              for (int ks = 0; ks < 2; ++ks) { const bf16x8 a = *(const LAS bf16x8*)(Vt + (16 * vt + fr) * 72 + 32 * ks + 8 * g); acc = __builtin_amdgcn_mfma_f32_16x16x32_bf16(a, bt[ks], acc, 0, 0, 0); }
              *(GAS unsigned long long*)(OI + ((size_t)cid * 64 + 16 * mt + fr) * DM + h * 128 + 16 * vt + 4 * g) = (unsigned long long)pk2(acc[0], acc[1]) | ((unsigned long long)pk2(acc[2], acc[3]) << 32); } }
        LDS_BAR();
    }
}
__device__ __forceinline__ void hgrn_scan_phase(const Frame& F0, const Args& A, int e) {
    Frame F = F0; asm volatile("" : "+v"(F.tid)); asm volatile("" : "+s"(F.vcu)); F.lane = F.tid & 63; F.wave = __builtin_amdgcn_readfirstlane(F.tid >> 6);
    const bf16* QH = (const bf16*)(F.ws + WS_QH); const bf16* KT = (const bf16*)(F.ws + WS_KT); const bf16* VT = (const bf16*)(F.ws + WS_VT); bf16* OX = (bf16*)(F.ws + WS_OX); const float* DD = (const float*)(F.ws + WS_DD);
    LAS bf16* ST = (LAS bf16*)F.lds;
    const int lane = F.lane, w = F.wave, fr = lane & 15, g = lane >> 4;
    for (int it = F.vcu; it < 768; it += F.G) {
        const bool samp = it >= 256; const int j = samp ? it - 256 : it; const int b = j >> 6, h = (j >> 3) & 7, vs = j & 7;
        const int nsteps = samp ? 1 : 64, cid0 = samp ? 256 + b : b * 64;
        float* sout = samp ? F.out + OHGRN_S + (((size_t)(e * SB + b) * 8 + h) * 128) * 128 : F.out + OHGRN_P + (((size_t)(e * NB + b) * 8 + h) * 128) * 128;
        f32x4 S = {0.f, 0.f, 0.f, 0.f};
        if (samp) { const float* s0 = A.in[3] + (((size_t)(e * SB + b) * 8 + h) * 128) * 128;
#pragma unroll
            for (int r = 0; r < 4; ++r) S[r] = s0[(size_t)(16 * w + 4 * g + r) * 128 + vs * 16 + fr]; }
        *(LAS unsigned long long*)(ST + fr * 136 + 16 * w + 4 * g) = (unsigned long long)pk2(S[0], S[1]) | ((unsigned long long)pk2(S[2], S[3]) << 32);
        LDS_BAR();
        bf16x8 ktf[2], vtf[2], qf[4]; f32x4 dd;
#define HG_LOAD(c) do { const size_t ch_ = (size_t)(cid0 + (c)) * 8 + h; \
            _Pragma("unroll") for (int ss = 0; ss < 2; ++ss) { ktf[ss] = *(const GAS bf16x8*)(KT + (ch_ * 128 + 16 * w + fr) * 64 + 32 * ss + 8 * g); vtf[ss] = *(const GAS bf16x8*)(VT + (ch_ * 128 + vs * 16 + fr) * 64 + 32 * ss + 8 * g); } \
            dd = *(const GAS f32x4*)(DD + ch_ * 128 + 16 * w + 4 * g); \
            if (w < 4) { _Pragma("unroll") for (int ks = 0; ks < 4; ++ks) qf[ks] = *(const GAS bf16x8*)(QH + ((size_t)(cid0 + (c)) * 64 + 16 * w + fr) * DM + h * 128 + 32 * ks + 8 * g); } } while (0)
        HG_LOAD(0);
        for (int c = 0; c < nsteps; ++c) {
            const bf16x8 k0 = ktf[0], k1 = ktf[1], v0 = vtf[0], v1 = vtf[1], q0 = qf[0], q1 = qf[1], q2 = qf[2], q3 = qf[3]; const f32x4 dcur = dd;
            if (c + 1 < nsteps) HG_LOAD(c + 1);
            const LAS bf16* stc = ST + (c & 1) * 16 * 136;
            if (w < 4) {
                f32x4 o = {0.f, 0.f, 0.f, 0.f};
                o = __builtin_amdgcn_mfma_f32_16x16x32_bf16(*(const LAS bf16x8*)(stc + fr * 136 + 0 + 8 * g), q0, o, 0, 0, 0);
                o = __builtin_amdgcn_mfma_f32_16x16x32_bf16(*(const LAS bf16x8*)(stc + fr * 136 + 32 + 8 * g), q1, o, 0, 0, 0);
                o = __builtin_amdgcn_mfma_f32_16x16x32_bf16(*(const LAS bf16x8*)(stc + fr * 136 + 64 + 8 * g), q2, o, 0, 0, 0);
                o = __builtin_amdgcn_mfma_f32_16x16x32_bf16(*(const LAS bf16x8*)(stc + fr * 136 + 96 + 8 * g), q3, o, 0, 0, 0);
                *(GAS unsigned long long*)(OX + ((size_t)(cid0 + c) * 64 + 16 * w + fr) * DM + h * 128 + vs * 16 + 4 * g) = (unsigned long long)pk2(o[0], o[1]) | ((unsigned long long)pk2(o[2], o[3]) << 32);
            }
            S = S * dcur;
            S = __builtin_amdgcn_mfma_f32_16x16x32_bf16(k0, v0, S, 0, 0, 0);
            S = __builtin_amdgcn_mfma_f32_16x16x32_bf16(k1, v1, S, 0, 0, 0);
            *(LAS unsigned long long*)(ST + ((c + 1) & 1) * 16 * 136 + fr * 136 + 16 * w + 4 * g) = (unsigned long long)pk2(S[0], S[1]) | ((unsigned long long)pk2(S[2], S[3]) << 32);
            LDS_BAR();
        }
#undef HG_LOAD
#pragma unroll
        for (int r = 0; r < 4; ++r) sout[(size_t)(16 * w + 4 * g + r) * 128 + vs * 16 + fr] = S[r];
        LDS_BAR();
    }
}
__device__ __forceinline__ void hgrn_combine_phase(const Frame& F0, const Args& A, int e) {
    Frame F = F0; asm volatile("" : "+v"(F.tid)); asm volatile("" : "+s"(F.vcu)); F.lane = F.tid & 63; F.wave = __builtin_amdgcn_readfirstlane(F.tid >> 6);
    const bf16* H = (const bf16*)(F.ws + WS_H); const bf16* OI = (const bf16*)(F.ws + WS_OI); const bf16* OX = (const bf16*)(F.ws + WS_OX); bf16* AO = (bf16*)(F.ws + WS_AO);
    const float* hg = A.in[13] + (size_t)e * 128;
    const size_t gt = (size_t)F.vcu * 512 + F.tid, NT = (size_t)F.G * 512;
    for (size_t i = gt; i < (size_t)MTOK * 128; i += NT) {
        const int row = (int)(i >> 7), seg = (int)(i & 127);
        const size_t crow = row < MP ? (size_t)row : (size_t)(256 + ((row - MP) >> 4)) * 64 + ((row - MP) & 15);
        const v4u a = *(const GAS v4u*)(OI + crow * DM + seg * 8), bq = *(const GAS v4u*)(OX + crow * DM + seg * 8), z = *(const GAS v4u*)(H + (size_t)row * IN_EVEN + 6144 + seg * 8);
        float o[8]; float ss = 0.f;
#pragma unroll
        for (int j = 0; j < 4; ++j) { o[2 * j] = bflo(a[j]) + bflo(bq[j]); o[2 * j + 1] = bfhi(a[j]) + bfhi(bq[j]); ss += o[2 * j] * o[2 * j] + o[2 * j + 1] * o[2 * j + 1]; }
        ss += __shfl_xor(ss, 1); ss += __shfl_xor(ss, 2); ss += __shfl_xor(ss, 4); ss += __shfl_xor(ss, 8);
        const float rs = 1.f / sqrtf(ss * (1.f / 128.f) + LN_EPS);
        const GAS f32x4* gp = (const GAS f32x4*)(hg + (seg & 15) * 8); const f32x4 g0 = gp[0], g1 = gp[1];
        const float gv[8] = {g0.x, g0.y, g0.z, g0.w, g1.x, g1.y, g1.z, g1.w};
        v4u r;
#pragma unroll
        for (int j = 0; j < 4; ++j) r[j] = pk2(o[2 * j] * rs * gv[2 * j] * siluf_(bflo(z[j])), o[2 * j + 1] * rs * gv[2 * j + 1] * siluf_(bfhi(z[j])));
        *(GAS v4u*)(AO + (size_t)row * 2048 + 1024 + seg * 8) = r;
    }
}
namespace att {
using f32x16 = __attribute__((ext_vector_type(16))) float;
using s16x4  = __attribute__((ext_vector_type(4))) short;
constexpr int LDH = 8192, KVBLK = 64;
constexpr float SCALE = 0.125f, THR = 8.f;
constexpr int SHM_V = 16384, SHM_K = 16384, LDS_T = 0, LDS_WS = 69632, T_STRIDE = 132;
#define KSWZ(row, colB) ((row) * 256 + ((colB) ^ (((row) & 7) << 4)))
#define SBAR() __builtin_amdgcn_sched_barrier(0)
__device__ __forceinline__ int crow(int r, int hi) { return (r & 3) + 8 * (r >> 2) + 4 * hi; }
__device__ __forceinline__ void partialSM(f32x16& p0, f32x16& p1, float& m_reg, float& mn, float& alpha) {
  constexpr float C = SCALE * 1.4426950408889634f;
  float pmax = p0[0];
#pragma unroll
  for (int r = 1; r < 16; ++r) pmax = fmaxf(pmax, p0[r]);
#pragma unroll
  for (int r = 0; r < 16; ++r) pmax = fmaxf(pmax, p1[r]);
  { auto rr = __builtin_amdgcn_permlane32_swap(__float_as_uint(pmax), __float_as_uint(pmax), false, false);
    pmax = fmaxf(__uint_as_float(rr[0]), __uint_as_float(rr[1])); }
  if (__builtin_expect(__all(pmax - m_reg <= THR / SCALE), 1)) { mn = m_reg; alpha = 1.f; }
  else { mn = fmaxf(m_reg, pmax); alpha = __builtin_amdgcn_exp2f((m_reg - mn) * C); m_reg = mn; }
  const float mnC = -mn * C;
#pragma unroll
  for (int r = 0; r < 16; ++r) p0[r] = fmaf(p0[r], C, mnC);
#pragma unroll
  for (int r = 0; r < 16; ++r) p1[r] = fmaf(p1[r], C, mnC);
#pragma unroll
  for (int r = 0; r < 16; ++r) p0[r] = __builtin_amdgcn_exp2f(p0[r]);
}
__device__ __forceinline__ void finishSM(f32x16& p0, f32x16& p1, float alpha, float& l_reg, bf16x8& pa0, bf16x8& pa1, bf16x8& pa2, bf16x8& pa3) {
#pragma unroll
  for (int r = 0; r < 16; ++r) p1[r] = __builtin_amdgcn_exp2f(p1[r]);
  float ps = 0;
#pragma unroll
  for (int r = 0; r < 16; ++r) ps += p0[r];
#pragma unroll
  for (int r = 0; r < 16; ++r) ps += p1[r];
  { auto rr = __builtin_amdgcn_permlane32_swap(__float_as_uint(ps), __float_as_uint(ps), false, false);
    ps = __uint_as_float(rr[0]) + __uint_as_float(rr[1]); }
  l_reg = l_reg * alpha + ps;
#define PK4(P, BASE, OUT) do { unsigned a0 = cvtpk(P[BASE + 0], P[BASE + 1]), a1 = cvtpk(P[BASE + 2], P[BASE + 3]);   \
    unsigned b0 = cvtpk(P[BASE + 4], P[BASE + 5]), b1 = cvtpk(P[BASE + 6], P[BASE + 7]);                              \
    auto r0 = __builtin_amdgcn_permlane32_swap(a0, b0, false, false); auto r1 = __builtin_amdgcn_permlane32_swap(a1, b1, false, false); \
    v4u w_ = {r0[0], r1[0], r0[1], r1[1]}; OUT = __builtin_bit_cast(bf16x8, w_); } while (0)
  PK4(p0, 0, pa0); PK4(p0, 8, pa1); PK4(p1, 0, pa2); PK4(p1, 8, pa3);
#undef PK4
}
__device__ __forceinline__ void qkt(f32x16& p0, f32x16& p1, const LAS char* Ks, const bf16x8* qr, int r32, int hi, int cbase) {
  p0 = f32x16{}; p1 = f32x16{};
#pragma unroll
  for (int d0 = 0; d0 < 4; ++d0) { const int cb = cbase + (d0 * 16 + hi * 8) * 2;
    const bf16x8 b0 = *(const LAS bf16x8*)(Ks + KSWZ(r32, cb));
    const bf16x8 b1 = *(const LAS bf16x8*)(Ks + KSWZ(32 + r32, cb));
    p0 = __builtin_amdgcn_mfma_f32_32x32x16_bf16(b0, qr[d0], p0, 0, 0, 0);
    p1 = __builtin_amdgcn_mfma_f32_32x32x16_bf16(b1, qr[d0], p1, 0, 0, 0); }
}
__device__ __forceinline__ int v_st(int k, int c) { const int kk = (k & ~0xC) | ((k & 4) << 1) | ((k & 8) >> 1); return ((kk >> 3) * 4 + (c >> 5)) * 512 + ((kk & 7) * 32 + (c & 31)) * 2; }
__device__ __forceinline__ int v_rd_base(int lane) { return ((lane & 3) << 3) | (((lane >> 2) & 3) << 6) | (((lane >> 4) & 1) << 5) | (((lane >> 5) & 1) << 8); }
constexpr int v_rd_off(int d0, int ks, int half) { return d0 * 512 + ks * 4096 + half * 2048; }
template <int OFF> __device__ __forceinline__ s16x4 tr_read(int vb) {
  s16x4 r; asm volatile("ds_read_b64_tr_b16 %0, %1 offset:%2" : "=&v"(r) : "v"(vb), "i"(OFF) : "memory"); return r;
}
template <int D0> __device__ __forceinline__ void pv_one(f32x16& od, int vb, bf16x8 pa0, bf16x8 pa1, bf16x8 pa2, bf16x8 pa3) {
  const s16x4 l0 = tr_read<v_rd_off(D0, 0, 0)>(vb), h0 = tr_read<v_rd_off(D0, 0, 1)>(vb), l1 = tr_read<v_rd_off(D0, 1, 0)>(vb), h1 = tr_read<v_rd_off(D0, 1, 1)>(vb);
  const s16x4 l2 = tr_read<v_rd_off(D0, 2, 0)>(vb), h2 = tr_read<v_rd_off(D0, 2, 1)>(vb), l3 = tr_read<v_rd_off(D0, 3, 0)>(vb), h3 = tr_read<v_rd_off(D0, 3, 1)>(vb);
  asm volatile("s_waitcnt lgkmcnt(0)" ::: "memory"); SBAR();
#define PK(L, H) (bf16x8){L[0], L[1], L[2], L[3], H[0], H[1], H[2], H[3]}
  od = __builtin_amdgcn_mfma_f32_32x32x16_bf16(pa0, PK(l0, h0), od, 0, 0, 0);
  od = __builtin_amdgcn_mfma_f32_32x32x16_bf16(pa1, PK(l1, h1), od, 0, 0, 0);
  od = __builtin_amdgcn_mfma_f32_32x32x16_bf16(pa2, PK(l2, h2), od, 0, 0, 0);
  od = __builtin_amdgcn_mfma_f32_32x32x16_bf16(pa3, PK(l3, h3), od, 0, 0, 0);
#undef PK
}
__device__ __forceinline__ void pv_d0(f32x16* o, int vb, bf16x8 pa0, bf16x8 pa1, bf16x8 pa2, bf16x8 pa3) {
  pv_one<0>(o[0], vb, pa0, pa1, pa2, pa3); pv_one<1>(o[1], vb, pa0, pa1, pa2, pa3); pv_one<2>(o[2], vb, pa0, pa1, pa2, pa3); pv_one<3>(o[3], vb, pa0, pa1, pa2, pa3);
}
__device__ __forceinline__ void attn_unit(const bf16* __restrict__ H, bf16* __restrict__ AO, const float* __restrict__ subg, int b, int h, int qb, float lam, float post, LAS char* lds) {
  int tid_ = threadIdx.x; asm volatile("" : "+v"(tid_)); const int tid = tid_, wid = __builtin_amdgcn_readfirstlane(tid >> 6), lane = tid & 63, r32 = lane & 31, hi = lane >> 5;
  const int map = wid >> 2, wq = wid & 3;
  LAS char* V_lds = lds; LAS char* K_lds = lds + 2 * SHM_V;
  LAS float* ws = (LAS float*)(lds + LDS_WS) + wid * 64; LAS float* li_l = ws; LAS float* al_l = ws + 32;
  const size_t rowbase = (size_t)b * SEQ; const int q0 = qb * 128;
  const bf16* Kh = H + rowbase * LDH + 2048 + h * 128; const bf16* Vh = H + rowbase * LDH + 4096 + h * 128;
  float m_reg = -1e30f, l_reg = 0; f32x16 o[4] = {}; bf16x8 qr[4];
  const bf16* Qw = H + (rowbase + q0 + wq * 32 + r32) * LDH + h * 128 + map * 64 + hi * 8;
#pragma unroll
  for (int d0 = 0; d0 < 4; ++d0) qr[d0] = *(const GAS bf16x8*)(Qw + d0 * 16);
  const int sr = tid >> 4, sc = (tid & 15) * 8, vst0 = v_st(sr, sc), vst1 = v_st(32 + sr, sc);
  const int vb0 = (int)(unsigned)(uintptr_t)V_lds + v_rd_base(lane);
  const int cbase = map * 128;
  struct { bf16x8 vs0, vs1, ks0, ks1; } sr_[1];
#define SLOAD(i, k0) do { sr_[i].vs0 = *(const GAS bf16x8*)(&Vh[(size_t)((k0) + sr) * LDH + sc]); sr_[i].vs1 = *(const GAS bf16x8*)(&Vh[(size_t)((k0) + 32 + sr) * LDH + sc]); \
    sr_[i].ks0 = *(const GAS bf16x8*)(&Kh[(size_t)((k0) + sr) * LDH + sc]); sr_[i].ks1 = *(const GAS bf16x8*)(&Kh[(size_t)((k0) + 32 + sr) * LDH + sc]); } while (0)
#define SWRITE(bq, i) do { *(LAS bf16x8*)(V_lds + (bq) * SHM_V + vst0) = sr_[i].vs0; *(LAS bf16x8*)(V_lds + (bq) * SHM_V + vst1) = sr_[i].vs1; const int kc = sc * 2; \
    *(LAS bf16x8*)(K_lds + (bq) * SHM_K + KSWZ(sr, kc)) = sr_[i].ks0; *(LAS bf16x8*)(K_lds + (bq) * SHM_K + KSWZ(32 + sr, kc)) = sr_[i].ks1; } while (0)
#define SWAIT() asm volatile("s_waitcnt vmcnt(0)" ::: "memory")
#define RESC(a) do { if (__any((a) < 1.f)) { if (hi == 0) al_l[r32] = (a); asm volatile("s_waitcnt lgkmcnt(0)" ::: "memory"); \
    _Pragma("unroll") for (int d = 0; d < 4; ++d) _Pragma("unroll") for (int r = 0; r < 16; ++r) o[d][r] *= al_l[crow(r, hi)]; } } while (0)
  f32x16 pA0, pA1, pB0, pB1; float mnA, mnB, alA, alB; bf16x8 pa0, pa1, pa2, pa3;
  const int NT = 2 * qb + 2; const bool full = wq >= 2;
  constexpr int SE = 0, SO = 0;
  SLOAD(SE, 0); asm volatile("s_waitcnt vmcnt(0)" ::: "memory"); SWRITE(0, SE); __syncthreads();
  qkt(pA0, pA1, K_lds, qr, r32, hi, cbase); partialSM(pA0, pA1, m_reg, mnA, alA);
  SLOAD(SO, KVBLK);
  SWAIT(); SWRITE(1, SO); __syncthreads();
  for (int j = 1; j + 1 < NT; j += 2) {
    SBAR(); qkt(pB0, pB1, K_lds + SHM_K, qr, r32, hi, cbase);
    finishSM(pA0, pA1, alA, l_reg, pa0, pa1, pa2, pa3); SBAR();
    SLOAD(SO, (j + 1) * KVBLK); SBAR();
    pv_d0(o, vb0, pa0, pa1, pa2, pa3); partialSM(pB0, pB1, m_reg, mnB, alB);
    __syncthreads(); SWAIT(); SWRITE(0, SE);
    RESC(alB); __syncthreads();
    SBAR(); qkt(pA0, pA1, K_lds, qr, r32, hi, cbase);
    finishSM(pB0, pB1, alB, l_reg, pa0, pa1, pa2, pa3); SBAR();
    SLOAD(SE, (j + 2) * KVBLK); SBAR();
    pv_d0(o, vb0 + SHM_V, pa0, pa1, pa2, pa3); partialSM(pA0, pA1, m_reg, mnA, alA);
    __syncthreads(); SWAIT(); SWRITE(1, SO);
    RESC(alA); __syncthreads();
  }
  SBAR(); if (full) qkt(pB0, pB1, K_lds + SHM_K, qr, r32, hi, cbase);
  finishSM(pA0, pA1, alA, l_reg, pa0, pa1, pa2, pa3); SBAR();
  pv_d0(o, vb0, pa0, pa1, pa2, pa3);
  if (full) { partialSM(pB0, pB1, m_reg, mnB, alB); RESC(alB);
    finishSM(pB0, pB1, alB, l_reg, pa0, pa1, pa2, pa3); SBAR();
    pv_d0(o, vb0 + SHM_V, pa0, pa1, pa2, pa3); }
  if (hi == 0) li_l[r32] = l_reg; asm volatile("s_waitcnt lgkmcnt(0)" ::: "memory");
  float rli[16];
#pragma unroll
  for (int r = 0; r < 16; ++r) rli[r] = __builtin_amdgcn_rcpf(li_l[crow(r, hi)]);
  __syncthreads();
  LAS float* T = (LAS float*)(lds + LDS_T);
  if (map == 1) {
#pragma unroll
    for (int r = 0; r < 16; ++r)
#pragma unroll
      for (int d0 = 0; d0 < 4; ++d0) T[(wq * 32 + crow(r, hi)) * T_STRIDE + d0 * 32 + r32] = lam * o[d0][r] * rli[r];
  }
  __syncthreads();
  if (map == 0) {
#pragma unroll
    for (int r = 0; r < 16; ++r)
#pragma unroll
      for (int d0 = 0; d0 < 4; ++d0) { LAS float* p = T + (wq * 32 + crow(r, hi)) * T_STRIDE + d0 * 32 + r32; *p = o[d0][r] * rli[r] - *p; }
  }
  __syncthreads();
  { const int row = tid >> 2, seg = tid & 3; const LAS f32x4* tp = (const LAS f32x4*)(T + row * T_STRIDE + seg * 32);
    f32x4 x[8]; float ss = 0.f;
#pragma unroll
    for (int i = 0; i < 8; ++i) { x[i] = tp[i]; ss += (x[i].x * x[i].x + x[i].y * x[i].y) + (x[i].z * x[i].z + x[i].w * x[i].w); }
    ss += __shfl_xor(ss, 1); ss += __shfl_xor(ss, 2);
    const float rs = post / sqrtf(ss * (1.f / 128.f) + LN_EPS);
    const size_t grow = rowbase + q0 + row;
    const GAS v4u* zp = (const GAS v4u*)(H + grow * LDH + 6144 + h * 128 + seg * 32); const GAS f32x4* gp = (const GAS f32x4*)(subg + seg * 32);
    GAS v4u* op = (GAS v4u*)(AO + grow * 2048 + h * 128 + seg * 32);
#pragma unroll
    for (int i = 0; i < 4; ++i) { const v4u z = zp[i]; const f32x4 g0 = gp[2 * i], g1 = gp[2 * i + 1]; const f32x4 a = x[2 * i] * rs * g0, c = x[2 * i + 1] * rs * g1;
      v4u r; r.x = pk2(a.x * bflo(z.x), a.y * bfhi(z.x)); r.y = pk2(a.z * bflo(z.y), a.w * bfhi(z.y)); r.z = pk2(c.x * bflo(z.z), c.y * bfhi(z.z)); r.w = pk2(c.z * bflo(z.w), c.w * bfhi(z.w));
      op[i] = r; } }
  __syncthreads();
#undef SLOAD
#undef SWRITE
#undef SWAIT
#undef RESC
}
#undef KSWZ
#undef SBAR
}

constexpr int SA_NSPLIT = 2, SA_NPART = SA_NSPLIT * 4;
constexpr int SA_KSTR = 136, SA_VSTR = 144;
constexpr int SA_PART_FLOATS = 2048 + 32;
__device__ __forceinline__ void sattn_phase(const Frame& F0, const Args& A, int o_idx) {
    Frame F = F0; asm volatile("" : "+v"(F.tid)); asm volatile("" : "+s"(F.vcu)); F.lane = F.tid & 63; F.wave = __builtin_amdgcn_readfirstlane(F.tid >> 6);
    const bf16* H = (const bf16*)(F.ws + WS_H); float* PART = (float*)(F.ws + WS_PART);
    LAS bf16* Ks = (LAS bf16*)F.lds;
    LAS bf16* Vs = Ks + 128 * SA_KSTR;
    const int tid = F.tid, lane = F.lane, w = F.wave, fr = lane & 15, g = lane >> 4, map = w >> 2, kq = w & 3;
    constexpr float C = 0.125f * 1.4426950408889634f;
    const int NKEY = PAST + SSEQ, NTILE = (NKEY + 127) / 128;
    for (int it = F.vcu; it < SB * 16 * SA_NSPLIT; it += F.G) {
        const int split = it % SA_NSPLIT, bh = it / SA_NSPLIT, b = bh >> 4, h = bh & 15;
        const int tile_lo = split * ((NTILE + SA_NSPLIT - 1) / SA_NSPLIT), tile_hi = min(NTILE, tile_lo + (NTILE + SA_NSPLIT - 1) / SA_NSPLIT);
        const float* Kc = A.in[4] + ((size_t)(o_idx * SB + b) * PAST) * 2048 + h * 128; const float* Vc = A.in[5] + ((size_t)(o_idx * SB + b) * PAST) * 2048 + h * 128;
        const float* Kn = F.out + OK_S + ((size_t)(o_idx * SB + b) * SSEQ) * 2048 + h * 128; const float* Vn = F.out + OV_S + ((size_t)(o_idx * SB + b) * SSEQ) * 2048 + h * 128;
        bf16x8 qf[2];
#pragma unroll
        for (int ds = 0; ds < 2; ++ds) qf[ds] = *(const GAS bf16x8*)(H + ((size_t)MP + b * SSEQ + fr) * 8192 + h * 128 + map * 64 + 32 * ds + 8 * g);
        float m_run = -1e30f, l_run = 0.f; f32x4 O[8];
#pragma unroll
        for (int vt = 0; vt < 8; ++vt) O[vt] = (f32x4){0.f, 0.f, 0.f, 0.f};
        const int lkey = tid >> 2, lq = tid & 3;
        f32x4 kreg[8], vreg[8];
#define SA_LOAD(t) do { const int key_ = (t) * 128 + lkey; \
            if (key_ < NKEY) { const float* kp_ = key_ < PAST ? Kc + (size_t)key_ * 2048 : Kn + (size_t)(key_ - PAST) * 2048; const float* vp_ = key_ < PAST ? Vc + (size_t)key_ * 2048 : Vn + (size_t)(key_ - PAST) * 2048; \
                _Pragma("unroll") for (int i = 0; i < 8; ++i) { kreg[i] = *(const GAS f32x4*)(kp_ + lq * 32 + 4 * i); vreg[i] = *(const GAS f32x4*)(vp_ + lq * 32 + 4 * i); } } \
            else { _Pragma("unroll") for (int i = 0; i < 8; ++i) { kreg[i] = (f32x4){0.f, 0.f, 0.f, 0.f}; vreg[i] = (f32x4){0.f, 0.f, 0.f, 0.f}; } } } while (0)
        SA_LOAD(tile_lo);
        for (int t = tile_lo; t < tile_hi; ++t) {
#pragma unroll
            for (int i = 0; i < 4; ++i) {
                *(LAS v4u*)(Ks + lkey * SA_KSTR + lq * 32 + 8 * i) = (v4u){cvtpk(kreg[2 * i].x, kreg[2 * i].y), cvtpk(kreg[2 * i].z, kreg[2 * i].w), cvtpk(kreg[2 * i + 1].x, kreg[2 * i + 1].y), cvtpk(kreg[2 * i + 1].z, kreg[2 * i + 1].w)};
                *(LAS v4u*)(Vs + lkey * SA_VSTR + lq * 32 + 8 * i) = (v4u){cvtpk(vreg[2 * i].x, vreg[2 * i].y), cvtpk(vreg[2 * i].z, vreg[2 * i].w), cvtpk(vreg[2 * i + 1].x, vreg[2 * i + 1].y), cvtpk(vreg[2 * i + 1].z, vreg[2 * i + 1].w)}; }
            LDS_BAR();
            if (t + 1 < tile_hi) SA_LOAD(t + 1);
            const int kb = kq * 32; f32x4 sA = {0.f, 0.f, 0.f, 0.f}, sB = {0.f, 0.f, 0.f, 0.f};
#pragma unroll
            for (int ds = 0; ds < 2; ++ds) {
                const bf16x8 ka = *(const LAS bf16x8*)(Ks + (kb + fr) * SA_KSTR + map * 64 + 32 * ds + 8 * g), kb2 = *(const LAS bf16x8*)(Ks + (kb + 16 + fr) * SA_KSTR + map * 64 + 32 * ds + 8 * g);
                sA = __builtin_amdgcn_mfma_f32_16x16x32_bf16(ka, qf[ds], sA, 0, 0, 0); sB = __builtin_amdgcn_mfma_f32_16x16x32_bf16(kb2, qf[ds], sB, 0, 0, 0); }
            const int key0 = t * 128 + kb + 4 * g;
            float sv[8]; float mx = -1e30f;
#pragma unroll
            for (int r = 0; r < 4; ++r) { sv[r] = (key0 + r < NKEY) ? sA[r] * C : -1e30f; sv[4 + r] = (key0 + 16 + r < NKEY) ? sB[r] * C : -1e30f; mx = fmaxf(mx, fmaxf(sv[r], sv[4 + r])); }
            mx = fmaxf(mx, __shfl_xor(mx, 16)); mx = fmaxf(mx, __shfl_xor(mx, 32));
            const float mn = fmaxf(m_run, mx), al = __builtin_amdgcn_exp2f(m_run - mn); m_run = mn;
            float ps = 0.f; float p[8];
#pragma unroll
            for (int r = 0; r < 8; ++r) { p[r] = __builtin_amdgcn_exp2f(sv[r] - mn); ps += p[r]; }
            l_run = l_run * al + ps;
            const v4u pw = {cvtpk(p[0], p[1]), cvtpk(p[2], p[3]), cvtpk(p[4], p[5]), cvtpk(p[6], p[7])}; const bf16x8 pb = __builtin_bit_cast(bf16x8, pw);
            const int vaddr = (int)(unsigned)(uintptr_t)(Vs + (kb + 4 * g + ((lane & 15) >> 2)) * SA_VSTR + 4 * (lane & 3));
#pragma unroll
            for (int vt = 0; vt < 8; ++vt) {
                att::s16x4 lo, hi2;
                asm volatile("ds_read_b64_tr_b16 %0, %1 offset:%2" : "=&v"(lo) : "v"(vaddr), "i"(vt * 32) : "memory");
                asm volatile("ds_read_b64_tr_b16 %0, %1 offset:%2" : "=&v"(hi2) : "v"(vaddr), "i"(vt * 32 + 16 * SA_VSTR * 2) : "memory");
                asm volatile("s_waitcnt lgkmcnt(0)" ::: "memory"); __builtin_amdgcn_sched_barrier(0);
                const bf16x8 va = {lo[0], lo[1], lo[2], lo[3], hi2[0], hi2[1], hi2[2], hi2[3]};
                O[vt] = O[vt] * al;
                O[vt] = __builtin_amdgcn_mfma_f32_16x16x32_bf16(va, pb, O[vt], 0, 0, 0);
            }
            LDS_BAR();
        }
#undef SA_LOAD
        l_run += __shfl_xor(l_run, 16); l_run += __shfl_xor(l_run, 32);
        float* pp = PART + ((size_t)((bh * 2 + map) * SA_NPART + split * 4 + kq)) * SA_PART_FLOATS;
#pragma unroll
        for (int vt = 0; vt < 8; ++vt)
#pragma unroll
            for (int r = 0; r < 4; ++r) pp[(16 * vt + 4 * g + r) * 16 + fr] = O[vt][r];
        if (g == 0) { pp[2048 + fr] = m_run; pp[2048 + 16 + fr] = l_run; }
    }
}
__device__ __forceinline__ void sattn_combine_phase(const Frame& F0, const Args& A, int o_idx, float lam, float post) {
    Frame F = F0; asm volatile("" : "+v"(F.tid)); asm volatile("" : "+s"(F.vcu)); F.lane = F.tid & 63; F.wave = __builtin_amdgcn_readfirstlane(F.tid >> 6);
    const bf16* H = (const bf16*)(F.ws + WS_H); const float* PART = (const float*)(F.ws + WS_PART); bf16* AO = (bf16*)(F.ws + WS_AO);
    const float* subg = A.in[20] + (size_t)o_idx * 128;
    const int tid = F.tid, q = tid >> 5, v0 = (tid & 31) * 4;
    for (int bh = F.vcu; bh < SB * 16; bh += F.G) {
        const int b = bh >> 4, h = bh & 15; float oc[4] = {0.f, 0.f, 0.f, 0.f};
#pragma unroll
        for (int map = 0; map < 2; ++map) {
            const float* pb = PART + (size_t)((bh * 2 + map) * SA_NPART) * SA_PART_FLOATS;
            float M = -1e30f;
            for (int i = 0; i < SA_NPART; ++i) M = fmaxf(M, pb[(size_t)i * SA_PART_FLOATS + 2048 + q]);
            float l = 0.f, acc[4] = {0.f, 0.f, 0.f, 0.f};
            for (int i = 0; i < SA_NPART; ++i) { const float* pi = pb + (size_t)i * SA_PART_FLOATS; const float sc = __builtin_amdgcn_exp2f(pi[2048 + q] - M); l += pi[2048 + 16 + q] * sc;
#pragma unroll
                for (int j = 0; j < 4; ++j) acc[j] += pi[(v0 + j) * 16 + q] * sc; }
            const float coef = (map == 0 ? 1.f : -lam) / l;
#pragma unroll
            for (int j = 0; j < 4; ++j) oc[j] += acc[j] * coef;
        }
        float ss = oc[0] * oc[0] + oc[1] * oc[1] + oc[2] * oc[2] + oc[3] * oc[3];
        ss += __shfl_xor(ss, 1); ss += __shfl_xor(ss, 2); ss += __shfl_xor(ss, 4); ss += __shfl_xor(ss, 8); ss += __shfl_xor(ss, 16);
        const float rs = post / sqrtf(ss * (1.f / 128.f) + LN_EPS);
        const size_t row = (size_t)MP + b * SSEQ + q;
        const unsigned long long z = *(const GAS unsigned long long*)(H + row * 8192 + 6144 + h * 128 + v0); const unsigned zl = (unsigned)z, zh = (unsigned)(z >> 32);
        const f32x4 gq = *(const GAS f32x4*)(subg + v0);
        *(GAS unsigned long long*)(AO + row * 2048 + h * 128 + v0) = (unsigned long long)pk2(oc[0] * rs * gq.x * bflo(zl), oc[1] * rs * gq.y * bfhi(zl)) | ((unsigned long long)pk2(oc[2] * rs * gq.z * bflo(zh), oc[3] * rs * gq.w * bfhi(zh)) << 32);
    }
}
#ifndef ONLY
#define ONLY -1
#endif
#define PH(n) (ONLY < 0 || ONLY == (n))
__device__ __forceinline__ float lam_of(const Args& A, int o_idx, float lam_init) {
    float s1 = 0.f, s2 = 0.f;
    for (int i = 0; i < 64; ++i) { s1 += A.in[16][o_idx * 64 + i] * A.in[17][o_idx * 64 + i]; s2 += A.in[18][o_idx * 64 + i] * A.in[19][o_idx * 64 + i]; }
    return __expf(s1) - __expf(s2) + lam_init;
}
__global__ void __launch_bounds__(NWAVES * 64, 2) fwd_kernel(Args A) {
    extern __shared__ __attribute__((aligned(16))) unsigned char lds_raw[];
    Frame F;
    F.lds = (LAS unsigned char*)lds_raw;
    F.MISC = (volatile LAS unsigned*)(F.lds + MISC_OFF);
    F.tid = threadIdx.x; F.lane = F.tid & 63; F.wave = __builtin_amdgcn_readfirstlane(F.tid >> 6);
    F.G = gridDim.x; { const int bx = blockIdx.x; F.vcu = (F.G % 8 == 0) ? (bx % 8) * (F.G / 8) + bx / 8 : bx; }
    F.out = A.out; F.ws = A.ws;
    if (F.tid < 64) F.MISC[F.tid] = 0u;
    __syncthreads();
    XcdBarrier bar = xcd_barrier_post((unsigned*)(F.ws + WS_CTL) + CW_BAR, F.MISC + 8);

    bf16* XB = (bf16*)(F.ws + WS_XB); float* X = (float*)(F.ws + WS_X); float* Y = (float*)(F.ws + WS_Y); bf16* AO = (bf16*)(F.ws + WS_AO); bf16* H = (bf16*)(F.ws + WS_H);
    if (PH(0)) p0_prologue(F, A);
    xcd_barrier(bar);
    for (int pr = 0; pr < 2; ++pr) {
        if (PH(1)) { pg8::Gemm g{XB, (const bf16*)(F.ws + WS_WIE) + (size_t)pr * IN_EVEN * DM, MPAD, IN_EVEN, DM}; pg8::StaticOrder S; S.init(MPAD, IN_EVEN, F.G, (int)blockIdx.x);
          pg8::EpiPlain E{H, IN_EVEN}; pg8::gemm_phase<pg8::EpiPlain, pg8::StaticOrder, true, true>(F.lds, g, S, E); }
        xcd_barrier(bar);
        if (PH(2)) hgrn_prep_phase(F, A, pr);
        if (PH(3)) conv_phase(F, A, pr);
        xcd_barrier(bar);
        if (PH(4)) hgrn_scan_phase(F, A, pr);
        xcd_barrier(bar);
        if (PH(5)) hgrn_combine_phase(F, A, pr);
        xcd_barrier(bar);
        if (PH(6)) { pg8::Gemm g{AO, (const bf16*)(F.ws + WS_WOE) + (size_t)pr * DM * 2048, MPAD, DM, 2048}; pg8::StaticOrder S; S.init(MPAD, DM, F.G, (int)blockIdx.x);
          pg8::EpiRes E{X, Y, ALPHA_RES}; pg8::gemm_phase<pg8::EpiRes, pg8::StaticOrder, true, true>(F.lds, g, S, E); }
        xcd_barrier(bar);
        if (PH(7)) ln_phase(F, A, 2 * pr, false);
        xcd_barrier(bar);
        if (PH(8)) { pg8::Gemm g{XB, (const bf16*)(F.ws + WS_WIO) + (size_t)pr * IN_ODD * DM, MPAD, IN_ODD, DM}; pg8::StaticOrder S; S.init(MPAD, IN_ODD, F.G, (int)blockIdx.x);
          pg8::EpiOdd E{H, F.out + OK_P + (size_t)pr * MP * 2048, F.out + OV_P + (size_t)pr * MP * 2048, F.out + OK_S + (size_t)pr * MS * 2048, F.out + OV_S + (size_t)pr * MS * 2048};
          pg8::gemm_phase<pg8::EpiOdd, pg8::StaticOrder, true, true>(F.lds, g, S, E); }
        xcd_barrier(bar);
        const float lam_init = pr == 0 ? 0.35550906759096924f : 0.55605820415755970f;
        const float lam = lam_of(A, pr, lam_init);
        if (PH(9)) for (int i = 0;; ++i) {
            const int idx = F.vcu + i * F.G; if (idx >= 2048) break;
            const int slot = idx >> 8, v = idx & 255, bh = v >> 2, s = v & 3, base = 4 * (slot >> 1) + s, qb = (slot & 1) ? 31 - base : base;
            att::attn_unit(H, AO, A.in[20] + (size_t)pr * 128, bh >> 4, bh & 15, qb, lam, 1.f - lam_init, (LAS char*)F.lds);
        }
        if (PH(10)) sattn_phase(F, A, pr);
        xcd_barrier(bar);
        if (PH(11)) sattn_combine_phase(F, A, pr, lam, 1.f - lam_init);
        xcd_barrier(bar);
        if (PH(12)) { pg8::Gemm g{AO, (const bf16*)(F.ws + WS_WOO) + (size_t)pr * DM * 2048, MPAD, DM, 2048}; pg8::StaticOrder S; S.init(MPAD, DM, F.G, (int)blockIdx.x);
          pg8::EpiRes E{X, Y, ALPHA_RES}; pg8::gemm_phase<pg8::EpiRes, pg8::StaticOrder, true, true>(F.lds, g, S, E); }
        xcd_barrier(bar);
        if (PH(13)) ln_phase(F, A, 2 * pr + 1, pr == 1);
        if (pr == 0) xcd_barrier(bar);
    }
}

extern "C" void kernel_launch(void* const* d_in, const int* in_sizes, int n_in, void* d_out, int out_size, void* d_ws, size_t ws_size, hipStream_t stream) {
    static int grid = 0;
    if (grid == 0) {
        if (n_in != 23 || (size_t)out_size != OUT_TOTAL || ws_size < WS_END) { fprintf(stderr, "kernel_launch: unexpected shapes: n_in %d out %d ws %zu\n", n_in, out_size, ws_size); grid = -1; return; }
        int dev = 0, cus = 0;
        if (hipGetDevice(&dev) != hipSuccess || hipDeviceGetAttribute(&cus, hipDeviceAttributeMultiprocessorCount, dev) != hipSuccess) { grid = -1; return; }
        if (hipFuncSetAttribute((const void*)fwd_kernel, hipFuncAttributeMaxDynamicSharedMemorySize, LDS_BYTES) != hipSuccess) { fprintf(stderr, "kernel_launch: hipFuncSetAttribute failed\n"); grid = -1; return; }
        int per_cu = 0;
        if (hipOccupancyMaxActiveBlocksPerMultiprocessor(&per_cu, (const void*)fwd_kernel, NWAVES * 64, LDS_BYTES) != hipSuccess || per_cu < 1) fprintf(stderr, "kernel_launch: occupancy query reports %d\n", per_cu);
        (void)hipGetLastError();
        grid = cus;
    }
    if (grid < 0) return;
    if (hipMemsetAsync((char*)d_ws + WS_CTL, 0, CTL_ZERO_BYTES, stream) != hipSuccess) { fprintf(stderr, "kernel_launch: memset failed\n"); return; }
    Args a{};
    for (int i = 0; i < 23; ++i) a.in[i] = (const float*)d_in[i];
    a.out = (float*)d_out; a.ws = (unsigned char*)d_ws;
    hipLaunchKernelGGL(fwd_kernel, dim3(grid), dim3(NWAVES * 64), LDS_BYTES, stream, a);
    const hipError_t le = hipPeekAtLastError();
    if (le != hipSuccess) fprintf(stderr, "kernel_launch: launch failed: %s\n", hipGetErrorName(le));
}
```

```cpp
#include <hip/hip_runtime.h>
#include <cstdio>
#include <cstdint>
namespace pg8 {
#define PG8_LAS __attribute__((address_space(3)))
typedef unsigned short bf16_t;
typedef short bf16x8 __attribute__((ext_vector_type(8)));
typedef float f32x4 __attribute__((ext_vector_type(4)));
typedef unsigned u32x4 __attribute__((ext_vector_type(4)));
constexpr int BM = 256, BK = 64, HALF = 128, HTB = HALF * BK * 2  , STAGE_BYTES = 8 * HTB, NXCD = 8, WGM = 8;

__host__ __device__ __forceinline__ int lds_byte(int r, int c) { const int st = (r >> 4) * 2 + (c >> 5), rr = r & 15, cc = c & 31, ob = rr * 64 + cc * 2; return st * 1024 + (ob ^ (((ob >> 9) & 1) << 5)); }
__host__ __device__ __forceinline__ void stage_rc(int b, int& R, int& C) { const int st = b / 1024, sb = b % 1024, swz = sb ^ (((sb >> 9) & 1) << 5); R = (st >> 1) * 16 + swz / 64; C = (st & 1) * 32 + (swz % 64) / 2; }
__host__ __device__ __forceinline__ int perm32(int rho) { const int n = rho >> 4, i = rho & 15; return 8 * (i >> 2) + 4 * n + (i & 3); }

struct Unit { int pm, pn; };
struct Gemm { const bf16_t* A; const bf16_t* Bt; int M, N, K; };

struct StaticOrder {
    int nM, nN, nwg, G, c;
    __host__ __device__ void init(int M, int N, int G_, int c_) { nM = M / BM; nN = N / BM; nwg = nM * nN; G = G_; c = c_; }
    __host__ __device__ bool next(int i, Unit& u) const {
        const long L = (long)i * G + c; if (L >= nwg) return false;
        int wgid = (int)L; { const int q = nwg / NXCD, r = nwg % NXCD, xcd = wgid % NXCD, off = wgid / NXCD; wgid = (xcd < r ? xcd * (q + 1) : r * (q + 1) + (xcd - r) * q) + off; }
        const int nig = WGM * nN, gid = wgid / nig, fm = gid * WGM, gsz = (nM - fm) < WGM ? (nM - fm) : WGM;
        u.pm = fm + ((wgid % nig) % gsz); u.pn = (wgid % nig) / gsz; return true;
    }
    __device__ __forceinline__ void a_ready(const Unit&) const {}
    __device__ __forceinline__ void done(const Unit&) const {}
};
__device__ __forceinline__ unsigned cvt_pk_bf16(float lo, float hi) { unsigned r; asm volatile("v_cvt_pk_bf16_f32 %0, %1, %2" : "=v"(r) : "v"(lo), "v"(hi)); return r; }
typedef float f32x2 __attribute__((ext_vector_type(2)));
struct EpiPlain {
    static constexpr bool PERM = true, AFTER_DRAIN = false;
    bf16_t* O; int ldc;
    __device__ __forceinline__ void operator()(const f32x4 (&acc)[2][2][4][2], const Unit& u, int wr, int wc, int fr, int fq) const {
        const int row0 = u.pm * BM + wr * 64 + fr, col0 = u.pn * BM + wc * 32 + 8 * fq;
#pragma unroll
        for (int ai = 0; ai < 2; ++ai)
#pragma unroll
            for (int m = 0; m < 4; ++m) { bf16_t* rowp = O + (size_t)(row0 + ai * HALF + m * 16) * ldc + col0;
#pragma unroll
                for (int bj = 0; bj < 2; ++bj) { const f32x4 v0 = acc[ai][bj][m][0], v1 = acc[ai][bj][m][1];
                    u32x4 w; w.x = cvt_pk_bf16(v0[0], v0[1]); w.y = cvt_pk_bf16(v0[2], v0[3]); w.z = cvt_pk_bf16(v1[0], v1[1]); w.w = cvt_pk_bf16(v1[2], v1[3]);
                    *(u32x4*)(rowp + bj * HALF) = w; } }
    }
};
struct EpiOdd {
    static constexpr bool PERM = true, AFTER_DRAIN = false;
    bf16_t* O; float* kp; float* vp; float* ks; float* vs;
    __device__ __forceinline__ void operator()(const f32x4 (&acc)[2][2][4][2], const Unit& u, int wr, int wc, int fr, int fq) const {
        const int row0 = u.pm * BM + wr * 64 + fr, colt = u.pn * BM, sect = colt >> 11, col0 = colt + wc * 32 + 8 * fq;
        float* pf = sect == 1 ? kp : vp; float* sf = sect == 1 ? ks : vs;
#pragma unroll
        for (int ai = 0; ai < 2; ++ai)
#pragma unroll
            for (int m = 0; m < 4; ++m) { const int row = row0 + ai * HALF + m * 16; bf16_t* rowp = O + (size_t)row * 8192 + col0;
#pragma unroll
                for (int bj = 0; bj < 2; ++bj) { f32x4 v0 = acc[ai][bj][m][0], v1 = acc[ai][bj][m][1];
                    if (sect == 3) {
#pragma unroll
                        for (int j = 0; j < 4; ++j) { v0[j] = v0[j] * __builtin_amdgcn_rcpf(1.f + __expf(-v0[j])); v1[j] = v1[j] * __builtin_amdgcn_rcpf(1.f + __expf(-v1[j])); } }
                    u32x4 w; w.x = cvt_pk_bf16(v0[0], v0[1]); w.y = cvt_pk_bf16(v0[2], v0[3]); w.z = cvt_pk_bf16(v1[0], v1[1]); w.w = cvt_pk_bf16(v1[2], v1[3]);
                    *(u32x4*)(rowp + bj * HALF) = w;
                    if (sect == 1 || sect == 2) { const int cc = col0 + bj * HALF - sect * 2048;
                        if (row < 16384) { float* d = pf + (size_t)row * 2048 + cc; *(f32x4*)d = v0; *(f32x4*)(d + 4) = v1; }
                        else if (row < 16512) { float* d = sf + (size_t)(row - 16384) * 2048 + cc; *(f32x4*)d = v0; *(f32x4*)(d + 4) = v1; } } } }
    }
};
struct EpiRes {
    static constexpr bool PERM = false, AFTER_DRAIN = false;
    const float* X; float* Y; float alpha;
    __device__ __forceinline__ void operator()(const f32x4 (&acc)[2][2][4][2], const Unit& u, int wr, int wc, int fr, int fq) const {
        const int row0 = u.pm * BM + wr * 64 + fr, col0 = u.pn * BM + wc * 32 + 4 * fq;
#pragma unroll
        for (int ai = 0; ai < 2; ++ai)
#pragma unroll
            for (int m = 0; m < 4; ++m) { const size_t off = (size_t)(row0 + ai * HALF + m * 16) * 1024 + col0;
#pragma unroll
                for (int bj = 0; bj < 2; ++bj)
#pragma unroll
                    for (int n = 0; n < 2; ++n) { const f32x4 xv = *(const f32x4*)(X + off + bj * HALF + n * 16); *(f32x4*)(Y + off + bj * HALF + n * 16) = acc[ai][bj][m][n] + xv * alpha; }
                asm volatile("" ::: "memory"); }
    }
};
template <class Epi, class Sched, bool ALIGN_EPI = false, bool SP2 = false>
__device__ __forceinline__ void gemm_phase(PG8_LAS unsigned char* lds, const Gemm g, const Sched& S, const Epi& E) {
    int tid_ = threadIdx.x; asm volatile("" : "+v"(tid_)); const int tid = tid_, wid = __builtin_amdgcn_readfirstlane(tid >> 6), lane = tid & 63, wr = wid >> 2, wc = wid & 3, fr = lane & 15, fq = lane >> 4;
    const int K = g.K, nt = K / BK;
    unsigned voffA[2], voffB[2];
#pragma unroll
    for (int i = 0; i < 2; ++i) { int R, C; stage_rc(tid * 16 + i * 8192, R, C); const int Rb = Epi::PERM ? ((R & ~31) + perm32(R & 31)) : R;
        voffA[i] = (unsigned)(R * K + C) * 2u; voffB[i] = (unsigned)(Rb * K + C) * 2u; }
    const size_t kstep = (size_t)(BK * 2);
    const size_t hstep = (size_t)HALF * K * 2;
    const size_t tstep = 2 * hstep;
    const unsigned ldsw = (unsigned)wid * 1024u;
    const int aoff = lds_byte(wr * 64 + fr, fq * 8), boff = lds_byte(wc * 32 + fr, fq * 8);
#define PG8_SA(b, h) (((b) * 2 + (h)) * HTB)
#define PG8_SB(b, h) ((4 + (b) * 2 + (h)) * HTB)
#define PG8_STAGE(bufoff, gbase, voff) do { _Pragma("unroll") for (int _i = 0; _i < 2; ++_i) \
        __builtin_amdgcn_global_load_lds((const unsigned*)((const char*)(gbase) + (voff)[_i]), (PG8_LAS unsigned*)(lds + (bufoff) + ldsw + _i * 8192), 16, 0, 0); } while (0)
#define PG8_LDA(dst, b, h) do { _Pragma("unroll") for (int m = 0; m < 4; ++m) _Pragma("unroll") for (int k = 0; k < 2; ++k) dst[m][k] = *(const PG8_LAS bf16x8*)(lds + PG8_SA(b, h) + aoff + m * 2048 + k * 1024); } while (0)
#define PG8_LDB(dst, b, h) do { _Pragma("unroll") for (int n = 0; n < 2; ++n) _Pragma("unroll") for (int k = 0; k < 2; ++k) dst[n][k] = *(const PG8_LAS bf16x8*)(lds + PG8_SB(b, h) + boff + n * 2048 + k * 1024); } while (0)
#define PG8_MMA(ai, bj, At, Bt) do { __builtin_amdgcn_s_setprio(1); _Pragma("unroll") for (int m = 0; m < 4; ++m) _Pragma("unroll") for (int n = 0; n < 2; ++n) _Pragma("unroll") for (int k = 0; k < 2; ++k) \
        acc[ai][bj][m][n] = __builtin_amdgcn_mfma_f32_16x16x32_bf16(Bt[n][k], At[m][k], acc[ai][bj][m][n], 0, 0, 0); __builtin_amdgcn_s_setprio(0); } while (0)
#define PG8_WAIT_V(n) asm volatile("s_waitcnt vmcnt(" #n ")" ::: "memory")
#define PG8_WAIT_L(n) asm volatile("s_waitcnt lgkmcnt(" #n ")" ::: "memory")
#define PG8_BAR __builtin_amdgcn_s_barrier()
#define PG8_SCHED __builtin_amdgcn_sched_barrier(0)
    Unit cur, nxt; int ui = 0;
    if (!S.next(0, cur)) return;
    f32x4 acc[2][2][4][2];
#pragma unroll
    for (int a = 0; a < 2; ++a)
#pragma unroll
        for (int b = 0; b < 2; ++b)
#pragma unroll
            for (int m = 0; m < 4; ++m)
#pragma unroll
                for (int n = 0; n < 2; ++n) acc[a][b][m][n] = (f32x4){0.f, 0.f, 0.f, 0.f};
    bf16x8 At[4][2], B0[2][2], B1[2][2];
    const char* cA = (const char*)g.A + (size_t)cur.pm * tstep; const char* cB = (const char*)g.Bt + (size_t)cur.pn * tstep;
    S.a_ready(cur);
    if constexpr (SP2) {
        PG8_STAGE(PG8_SB(0, 0), cB, voffB); PG8_STAGE(PG8_SB(0, 1), cB + hstep, voffB); PG8_STAGE(PG8_SA(0, 0), cA, voffA); PG8_STAGE(PG8_SA(0, 1), cA + hstep, voffA);
        if (wr == 1) PG8_BAR;
        PG8_WAIT_V(2); PG8_BAR;
        PG8_STAGE(PG8_SB(1, 0), cB + kstep, voffB); PG8_STAGE(PG8_SA(1, 0), cA + kstep, voffA); PG8_STAGE(PG8_SB(1, 1), cB + hstep + kstep, voffB);
        PG8_WAIT_V(6); PG8_BAR;
    } else {
        PG8_STAGE(PG8_SB(0, 0), cB, voffB); PG8_STAGE(PG8_SA(0, 0), cA, voffA); PG8_STAGE(PG8_SB(0, 1), cB + hstep, voffB); PG8_STAGE(PG8_SA(0, 1), cA + hstep, voffA);
        if (wr == 1) PG8_BAR;
        PG8_WAIT_V(4); PG8_BAR;
        PG8_STAGE(PG8_SB(1, 0), cB + kstep, voffB); PG8_STAGE(PG8_SA(1, 0), cA + kstep, voffA); PG8_STAGE(PG8_SB(1, 1), cB + hstep + kstep, voffB);
        PG8_WAIT_V(6); PG8_BAR;
    }
    for (;;) {
        const bool has_next = S.next(ui + 1, nxt);
        const char* nA = has_next ? (const char*)g.A + (size_t)nxt.pm * tstep : cA; const char* nB = has_next ? (const char*)g.Bt + (size_t)nxt.pn * tstep : cB;
        for (int t = 0; t < nt; t += 2) {
            const bool last = (t == nt - 2);
            const char* a1 = cA + (size_t)(t + 1) * kstep;
            const char* a2 = last ? nA : cA + (size_t)(t + 2) * kstep; const char* b2 = last ? nB : cB + (size_t)(t + 2) * kstep;
            const char* a3 = a2 + kstep; const char* b3 = b2 + kstep;
            if (last && has_next) S.a_ready(nxt);
            if constexpr (SP2) {
            PG8_LDB(B0, 0, 0); PG8_LDB(B1, 0, 1); PG8_SCHED; PG8_LDA(At, 0, 0); PG8_STAGE(PG8_SA(1, 1), a1 + hstep, voffA);
            PG8_WAIT_V(8); PG8_WAIT_L(0); PG8_BAR; PG8_MMA(0, 0, At, B0); PG8_MMA(0, 1, At, B1); PG8_BAR; PG8_SCHED;
            PG8_LDA(At, 0, 1); PG8_STAGE(PG8_SB(0, 0), b2, voffB); PG8_STAGE(PG8_SB(0, 1), b2 + hstep, voffB); PG8_STAGE(PG8_SA(0, 0), a2, voffA);
            PG8_WAIT_V(8); PG8_WAIT_L(0); PG8_BAR; PG8_MMA(1, 0, At, B0); PG8_MMA(1, 1, At, B1); PG8_BAR; PG8_SCHED;
            PG8_LDB(B0, 1, 0); PG8_LDB(B1, 1, 1); PG8_SCHED; PG8_LDA(At, 1, 0); PG8_STAGE(PG8_SA(0, 1), a2 + hstep, voffA);
            PG8_WAIT_V(8); PG8_WAIT_L(0); PG8_BAR; PG8_MMA(0, 0, At, B0); PG8_MMA(0, 1, At, B1); PG8_BAR; PG8_SCHED;
            PG8_LDA(At, 1, 1); PG8_STAGE(PG8_SB(1, 0), b3, voffB); PG8_STAGE(PG8_SB(1, 1), b3 + hstep, voffB); PG8_STAGE(PG8_SA(1, 0), a3, voffA);
            PG8_WAIT_V(8); PG8_WAIT_L(0); PG8_BAR; PG8_MMA(1, 0, At, B0); PG8_MMA(1, 1, At, B1); PG8_BAR; PG8_SCHED;
            } else {
            PG8_LDB(B0, 0, 0); PG8_SCHED; PG8_LDA(At, 0, 0); PG8_STAGE(PG8_SA(1, 1), a1 + hstep, voffA);
            PG8_WAIT_L(8); PG8_BAR; PG8_WAIT_L(0); PG8_MMA(0, 0, At, B0); PG8_BAR; PG8_SCHED;
            PG8_LDB(B1, 0, 1); PG8_STAGE(PG8_SB(0, 0), b2, voffB);
            PG8_BAR; PG8_WAIT_L(0); PG8_MMA(0, 1, At, B1); PG8_BAR;
            PG8_LDA(At, 0, 1); PG8_STAGE(PG8_SA(0, 0), a2, voffA);
            PG8_BAR; PG8_WAIT_L(0); PG8_MMA(1, 0, At, B0); PG8_BAR; PG8_SCHED;
            PG8_STAGE(PG8_SB(0, 1), b2 + hstep, voffB);
            PG8_WAIT_V(6); PG8_BAR; PG8_MMA(1, 1, At, B1); PG8_BAR;
            PG8_LDB(B0, 1, 0); PG8_SCHED; PG8_LDA(At, 1, 0); PG8_STAGE(PG8_SA(0, 1), a2 + hstep, voffA);
            PG8_WAIT_L(8); PG8_BAR; PG8_WAIT_L(0); PG8_MMA(0, 0, At, B0); PG8_BAR; PG8_SCHED;
            PG8_LDB(B1, 1, 1); PG8_STAGE(PG8_SB(1, 0), b3, voffB);
            PG8_BAR; PG8_WAIT_L(0); PG8_MMA(0, 1, At, B1); PG8_BAR;
            PG8_LDA(At, 1, 1); PG8_STAGE(PG8_SA(1, 0), a3, voffA);
            PG8_BAR; PG8_WAIT_L(0); PG8_MMA(1, 0, At, B0); PG8_BAR; PG8_SCHED;
            PG8_STAGE(PG8_SB(1, 1), b3 + hstep, voffB);
            PG8_WAIT_V(6); PG8_BAR; PG8_MMA(1, 1, At, B1); PG8_BAR;
            }
        }
        if constexpr (ALIGN_EPI) { if (wr == 0) PG8_BAR; }
        if constexpr (!Epi::AFTER_DRAIN) { E(acc, cur, wr, wc, fr, fq); S.done(cur); }
        if (!has_next) break;
#pragma unroll
        for (int a = 0; a < 2; ++a)
#pragma unroll
            for (int b = 0; b < 2; ++b)
#pragma unroll
                for (int m = 0; m < 4; ++m)
#pragma unroll
                    for (int n = 0; n < 2; ++n) acc[a][b][m][n] = (f32x4){0.f, 0.f, 0.f, 0.f};
        cur = nxt; cA = nA; cB = nB; ++ui;
        if constexpr (ALIGN_EPI) { if (wr == 1) PG8_BAR; }
    }
    PG8_WAIT_V(0);
    if constexpr (!ALIGN_EPI) { if (wr == 0) PG8_BAR; }
    PG8_BAR;
    if constexpr (Epi::AFTER_DRAIN) { E.fused(acc, cur, wr, wc, fr, fq, lds, wid, lane); S.done(cur); }
#undef PG8_SA
#undef PG8_SB
#undef PG8_STAGE
#undef PG8_LDA
#undef PG8_LDB
#undef PG8_MMA
#undef PG8_WAIT_V
#undef PG8_WAIT_L
#undef PG8_BAR
#undef PG8_SCHED
}
}
#define GAS __attribute__((address_space(1)))
#define LAS __attribute__((address_space(3)))
typedef unsigned short bf16;
typedef unsigned v4u __attribute__((ext_vector_type(4)));
typedef float f32x4 __attribute__((ext_vector_type(4)));
typedef short bf16x8 __attribute__((ext_vector_type(8)));
typedef GAS unsigned gu32;
typedef GAS unsigned long long gu64;
#define RLX_AGENT __ATOMIC_RELAXED, __HIP_MEMORY_SCOPE_AGENT
#define LDS_WAIT() asm volatile("s_waitcnt lgkmcnt(0)" ::: "memory")
#define VM_WAIT() asm volatile("s_waitcnt vmcnt(0)" ::: "memory")
__device__ __forceinline__ unsigned long long rt() { return __builtin_amdgcn_s_memrealtime(); }
__device__ __forceinline__ unsigned f2bf(float f) { unsigned u = __builtin_bit_cast(unsigned, f); return (u + 0x7fffu + ((u >> 16) & 1u)) >> 16; }
__device__ __forceinline__ unsigned pk2(float lo, float hi) { return f2bf(lo) | (f2bf(hi) << 16); }

#define XB_TMO      128
#define XB_XCNT(j)  (256  + 64 * (j))
#define XB_XSUB(j)  (1280 + 64 * (j))
#define XB_XGEN(j)  (2304 + 64 * (j))
#define XB_TOP      3328
#define XB_TOPGEN   3392
#define XCD_BAR_WORDS 3456
#define XB_SPIN_CAP (1u << 24)

__device__ __forceinline__ unsigned xb_ld(unsigned* p)              { return __hip_atomic_load(p, __ATOMIC_RELAXED, __HIP_MEMORY_SCOPE_AGENT); }
__device__ __forceinline__ unsigned xb_add(unsigned* p, unsigned v) { return __hip_atomic_fetch_add(p, v, __ATOMIC_RELAXED, __HIP_MEMORY_SCOPE_AGENT); }
__device__ __forceinline__ unsigned xb_xcc_id() { return (unsigned)__builtin_amdgcn_s_getreg((3 << 11) | 20) & 0xFu; }
#define XB_SPIN(cond, bar) do { unsigned _sp = 0; while (cond) { __builtin_amdgcn_s_sleep(1); \
    if ((++_sp & 255u) == 0u) { if (xb_ld(&(bar)[XB_TMO])) break; if (_sp > XB_SPIN_CAP) { atomicAdd(&(bar)[XB_TMO], 1u); break; } } } } while (0)

struct XcdBarrier {
    unsigned* bar; unsigned x;
    volatile LAS unsigned* st;
};

__device__ __forceinline__ XcdBarrier xcd_barrier_post(unsigned* bar, volatile LAS unsigned* st) {
    XcdBarrier b; b.bar = bar; b.x = xb_xcc_id(); b.st = st;
    if (threadIdx.x == 0) (void)xb_add(&bar[XB_XCNT(b.x)], 1u);
    return b;
}
__device__ __forceinline__ void xcd_barrier_complete(unsigned* bar, unsigned x, unsigned& nloc, unsigned& nx) {
    const unsigned G = gridDim.x * gridDim.y * gridDim.z;
    unsigned sum, cnt, mine, sp = 0u;
    for (;;) {
        sum = 0u; cnt = 0u; mine = 0u;
#pragma unroll
        for (unsigned j = 0; j < 16; ++j) { const unsigned c = xb_ld(&bar[XB_XCNT(j)]); sum += c; cnt += (c > 0u) ? 1u : 0u; mine = (j == x) ? c : mine; }
        if (sum == G) break;
        __builtin_amdgcn_s_sleep(1);
        if ((++sp & 255u) == 0u) { if (xb_ld(&bar[XB_TMO])) break; if (sp > XB_SPIN_CAP) { atomicAdd(&bar[XB_TMO], 1u); break; } }
    }
    nloc = mine > 0u ? mine : 1u; nx = cnt > 0u ? cnt : 1u;
}

__device__ __forceinline__ void xcd_barrier(const XcdBarrier& b) {
    asm volatile("s_waitcnt vmcnt(0)" ::: "memory");
    __syncthreads();
    if (threadIdx.x == 0) {
        unsigned* bar = b.bar; unsigned bx_ = b.x; asm volatile("" : "+s"(bx_), "+s"(bar));
        __builtin_amdgcn_s_waitcnt(0);
        unsigned nloc = b.st[0], nx = b.st[1];
        if (nloc == 0u) { xcd_barrier_complete(bar, bx_, nloc, nx); b.st[0] = nloc; b.st[1] = nx; }
        const unsigned old = xb_add(&bar[XB_XSUB(bx_)], 1u);
        const unsigned gen = old / nloc;
        if (old + 1u == (gen + 1u) * nloc) {
            __builtin_amdgcn_fence(__ATOMIC_RELEASE, "agent");
            asm volatile("s_waitcnt vmcnt(0)" ::: "memory");
            const unsigned og = xb_add(&bar[XB_TOP], 1u);
            const unsigned tg = og / nx;
            if (og + 1u == (tg + 1u) * nx) xb_add(&bar[XB_TOPGEN], 1u);
            else XB_SPIN(xb_ld(&bar[XB_TOPGEN]) == tg, bar);
            __builtin_amdgcn_fence(__ATOMIC_ACQUIRE, "agent");
            xb_add(&bar[XB_XGEN(bx_)], 1u);
            asm volatile("s_waitcnt vmcnt(0)" ::: "memory");
        } else {
            XB_SPIN(xb_ld(&bar[XB_XGEN(bx_)]) == gen, bar);
            __builtin_amdgcn_fence(__ATOMIC_ACQUIRE, "agent");
            asm volatile("s_waitcnt vmcnt(0)" ::: "memory");
        }
    }
    __syncthreads();
}
constexpr int NWAVES = 8;
constexpr int DM = 1024, NB = 4, SEQ = 4096, SB = 8, SSEQ = 16, PAST = 4096;
constexpr int MP = NB * SEQ, MS = SB * SSEQ, MTOK = MP + MS, MPAD = 16640;
constexpr int IN_EVEN = 7168, IN_ODD = 8192;
constexpr int NCHUNK = 256 + 8;
constexpr float LN_EPS = 1e-5f;
constexpr float ALPHA_RES = 1.6817928305074290f;
constexpr size_t OY_P = 0, OY_S = 16777216, OCONV_P = 16908288, OHGRN_P = 17154048, OK_P = 18202624, OV_P = 85311488, OCONV_S = 152420352, OHGRN_S = 152911872, OK_S = 155009024, OV_S = 155533312, OUT_TOTAL = 156057600;
constexpr size_t MiB = 1u << 20;
constexpr size_t WS_CTL = 0, CTL_ZERO_BYTES = 1 * MiB;
constexpr size_t WS_WIE = 2 * MiB, WS_WOE = 30 * MiB, WS_WIO = 38 * MiB, WS_WOO = 70 * MiB;
constexpr size_t WS_XB = 80 * MiB, WS_X = 114 * MiB, WS_Y = 180 * MiB, WS_AO = 246 * MiB, WS_H = 312 * MiB;
constexpr size_t WS_QH = 572 * MiB, WS_KT = 606 * MiB, WS_VT = 640 * MiB, WS_OI = 674 * MiB, WS_OX = 708 * MiB, WS_DD = 742 * MiB, WS_PART = 744 * MiB, WS_END = 768 * MiB;
constexpr int CW_BAR = 4096;
constexpr int LDS_BYTES = 147456;
constexpr int MISC_OFF = 146432;

struct Frame {
    LAS unsigned char* lds;
    volatile LAS unsigned* MISC;
    int tid, lane, wave, vcu, G;
    float* out; unsigned char* ws;
};
struct Args { const float* in[23]; float* out; unsigned char* ws; };
__device__ __forceinline__ float bf2f(unsigned short b) { return __uint_as_float(((unsigned)b) << 16); }
__device__ __forceinline__ float bflo(unsigned w) { return __uint_as_float(w << 16); }
__device__ __forceinline__ float bfhi(unsigned w) { return __uint_as_float(w & 0xffff0000u); }
__device__ __forceinline__ unsigned cvtpk(float lo, float hi) { unsigned r; asm volatile("v_cvt_pk_bf16_f32 %0, %1, %2" : "=v"(r) : "v"(lo), "v"(hi)); return r; }
__device__ __forceinline__ float sigmoidf_(float x) { return __builtin_amdgcn_rcpf(1.f + __expf(-x)); }
__device__ __forceinline__ float siluf_(float x) { return x * sigmoidf_(x); }
__device__ __forceinline__ float wave_sum(float v) {
#pragma unroll
    for (int o = 1; o < 64; o <<= 1) v += __shfl_xor(v, o);
    return v;
}
#define WG_BAR() do { asm volatile("s_waitcnt vmcnt(0) lgkmcnt(0)" ::: "memory"); __builtin_amdgcn_s_barrier(); asm volatile("" ::: "memory"); } while (0)
#define LDS_BAR() do { asm volatile("s_waitcnt lgkmcnt(0)" ::: "memory"); __builtin_amdgcn_s_barrier(); asm volatile("" ::: "memory"); } while (0)

template <class Epi> __device__ __forceinline__ void small_gemm(const Frame& F0, const bf16* A_, const bf16* Wt, int N, int K, const Epi& epi) {
    Frame F = F0; asm volatile("" : "+v"(F.tid)); asm volatile("" : "+s"(F.vcu)); F.lane = F.tid & 63; F.wave = __builtin_amdgcn_readfirstlane(F.tid >> 6);
    const int fr = F.lane & 15, g = F.lane >> 4, w = F.wave, tid = F.tid;
    LAS bf16* As = (LAS bf16*)F.lds;
    const int nch = K / 256;
    for (int unit = F.vcu; unit < N / 128; unit += F.G) {
        const bf16* bp = Wt + (size_t)(unit * 128 + 16 * w + fr) * K + 8 * g;
        f32x4 acc[8];
#pragma unroll
        for (int rt = 0; rt < 8; ++rt) acc[rt] = (f32x4){0.f, 0.f, 0.f, 0.f};
        v4u st[8]; bf16x8 bq[8];
#define SG_LOAD(kc) do { _Pragma("unroll") for (int i = 0; i < 8; ++i) { const int idx = tid + 512 * i; st[i] = *(const GAS v4u*)(A_ + (size_t)(idx >> 5) * K + (kc) * 256 + (idx & 31) * 8); } \
            _Pragma("unroll") for (int ks = 0; ks < 8; ++ks) bq[ks] = *(const GAS bf16x8*)(bp + (kc) * 256 + 32 * ks); } while (0)
        SG_LOAD(0);
        for (int kc = 0; kc < nch; ++kc) {
            LAS bf16* ab = As + (kc & 1) * 128 * 264;
#pragma unroll
            for (int i = 0; i < 8; ++i) { const int idx = tid + 512 * i; *(LAS v4u*)(ab + (idx >> 5) * 264 + (idx & 31) * 8) = st[i]; }
            bf16x8 bc[8];
#pragma unroll
            for (int ks = 0; ks < 8; ++ks) bc[ks] = bq[ks];
            LDS_BAR();
            if (kc + 1 < nch) SG_LOAD(kc + 1);
#pragma unroll
            for (int ks = 0; ks < 8; ++ks)
#pragma unroll
                for (int rt = 0; rt < 8; ++rt) { const bf16x8 a = *(const LAS bf16x8*)(ab + (16 * rt + fr) * 264 + 32 * ks + 8 * g); acc[rt] = __builtin_amdgcn_mfma_f32_16x16x32_bf16(bc[ks], a, acc[rt], 0, 0, 0); }
        }
#undef SG_LOAD
#pragma unroll
        for (int rt = 0; rt < 8; ++rt) epi(16 * rt + fr, unit * 128 + 16 * w + 4 * g, acc[rt]);
        LDS_BAR();
    }
}
struct SEpiPlain { bf16* H; int ld;
    __device__ __forceinline__ void operator()(int r, int c, f32x4 v) const { *(GAS unsigned long long*)(H + (size_t)(MP + r) * ld + c) = (unsigned long long)cvtpk(v.x, v.y) | ((unsigned long long)cvtpk(v.z, v.w) << 32); } };
struct SEpiOdd { bf16* H; float* ks; float* vs;
    __device__ __forceinline__ void operator()(int r, int c, f32x4 v) const { const int sect = c >> 11;
        if (sect == 1) *(GAS f32x4*)(ks + (size_t)r * 2048 + (c - 2048)) = v;
        if (sect == 2) *(GAS f32x4*)(vs + (size_t)r * 2048 + (c - 4096)) = v;
        if (sect == 3) { v.x = siluf_(v.x); v.y = siluf_(v.y); v.z = siluf_(v.z); v.w = siluf_(v.w); }
        *(GAS unsigned long long*)(H + (size_t)(MP + r) * 8192 + c) = (unsigned long long)cvtpk(v.x, v.y) | ((unsigned long long)cvtpk(v.z, v.w) << 32); } };
struct SEpiRes { const float* X; float* Y; float alpha;
    __device__ __forceinline__ void operator()(int r, int c, f32x4 v) const { const size_t o = (size_t)(MP + r) * DM + c; *(GAS f32x4*)(Y + o) = v + *(const GAS f32x4*)(X + o) * alpha; } };
__device__ __forceinline__ void p0_transpose_item(const float* W, int K, int N, bf16* WT, LAS float* scr, int item, int lane) {
    const int nblk = N / 32, kb = item / nblk, nb = item % nblk, k0 = 64 * kb, n0 = 32 * nb;
#pragma unroll 8
    for (int i = 0; i < 32; ++i) { const int kk = 2 * i + (lane >> 5); scr[kk * 33 + (lane & 31)] = W[(size_t)(k0 + kk) * N + n0 + (lane & 31)]; }
    LDS_WAIT(); asm volatile("" ::: "memory");
    const int c = lane & 7;
#pragma unroll
    for (int j = 0; j < 4; ++j) { const int n = (lane >> 3) + 8 * j; const LAS float* s = scr + (8 * c) * 33 + n;
        v4u o; o.x = pk2(s[0 * 33], s[1 * 33]); o.y = pk2(s[2 * 33], s[3 * 33]); o.z = pk2(s[4 * 33], s[5 * 33]); o.w = pk2(s[6 * 33], s[7 * 33]);
        *(GAS v4u*)(WT + (size_t)(n0 + n) * K + k0 + 8 * c) = o; }
    LDS_WAIT(); asm volatile("" ::: "memory");
}
__device__ __forceinline__ void p0_prologue(const Frame& F0, const Args& A) {
    Frame F = F0; asm volatile("" : "+v"(F.tid)); asm volatile("" : "+s"(F.vcu)); F.lane = F.tid & 63; F.wave = __builtin_amdgcn_readfirstlane(F.tid >> 6);
    LAS float* scr = (LAS float*)(F.lds + F.wave * 16384);
    const int gw = F.vcu * NWAVES + F.wave, NGW = F.G * NWAVES;
    constexpr int I_IE = (DM / 64) * (IN_EVEN / 32), I_OE = (2048 / 64) * (DM / 32), I_IO = (DM / 64) * (IN_ODD / 32), I_OO = I_OE;
    constexpr int PER = I_IE + I_OE + I_IO + I_OO;
    for (int it = gw; it < 2 * PER; it += NGW) {
        const int l = it / PER; int r = it - l * PER;
        if (r < I_IE) { p0_transpose_item(A.in[6] + (size_t)l * DM * IN_EVEN, DM, IN_EVEN, (bf16*)(F.ws + WS_WIE) + (size_t)l * IN_EVEN * DM, scr, r, F.lane); continue; } r -= I_IE;
        if (r < I_OE) { p0_transpose_item(A.in[7] + (size_t)l * 2048 * DM, 2048, DM, (bf16*)(F.ws + WS_WOE) + (size_t)l * DM * 2048, scr, r, F.lane); continue; } r -= I_OE;
        if (r < I_IO) { p0_transpose_item(A.in[14] + (size_t)l * DM * IN_ODD, DM, IN_ODD, (bf16*)(F.ws + WS_WIO) + (size_t)l * IN_ODD * DM, scr, r, F.lane); continue; } r -= I_IO;
        p0_transpose_item(A.in[15] + (size_t)l * 2048 * DM, 2048, DM, (bf16*)(F.ws + WS_WOO) + (size_t)l * DM * 2048, scr, r, F.lane);
    }
    float* X = (float*)(F.ws + WS_X); bf16* XB = (bf16*)(F.ws + WS_XB); bf16* AO = (bf16*)(F.ws + WS_AO);
    for (int m = gw; m < MPAD; m += NGW) {
        GAS unsigned long long* o8 = (GAS unsigned long long*)(XB + (size_t)m * DM) + F.lane;
        if (m < MTOK) {
            const float* src = m < MP ? A.in[0] + (size_t)m * DM : A.in[1] + (size_t)(m - MP) * DM;
            const GAS f32x4* xr = (const GAS f32x4*)src + F.lane; GAS f32x4* xo = (GAS f32x4*)(X + (size_t)m * DM) + F.lane;
#pragma unroll
            for (int j = 0; j < 4; ++j) { const f32x4 v = xr[64 * j]; xo[64 * j] = v; o8[64 * j] = (unsigned long long)pk2(v.x, v.y) | ((unsigned long long)pk2(v.z, v.w) << 32); }
        } else {
#pragma unroll
            for (int j = 0; j < 4; ++j) o8[64 * j] = 0ull;
            GAS v4u* a = (GAS v4u*)(AO + (size_t)m * 2048) + F.lane;
#pragma unroll
            for (int j = 0; j < 4; ++j) a[64 * j] = (v4u){0u, 0u, 0u, 0u};
        }
    }
}
__device__ __forceinline__ void ln_phase(const Frame& F0, const Args& A, int layer, bool last) {
    Frame F = F0; asm volatile("" : "+v"(F.tid)); asm volatile("" : "+s"(F.vcu)); F.lane = F.tid & 63; F.wave = __builtin_amdgcn_readfirstlane(F.tid >> 6);
    const int gw = F.vcu * NWAVES + F.wave, NGW = F.G * NWAVES;
    const float* Y = (const float*)(F.ws + WS_Y); float* X = (float*)(F.ws + WS_X); bf16* XB = (bf16*)(F.ws + WS_XB);
    const GAS f32x4* gp = (const GAS f32x4*)(A.in[21] + (size_t)layer * DM) + F.lane; const GAS f32x4* bp = (const GAS f32x4*)(A.in[22] + (size_t)layer * DM) + F.lane;
    f32x4 g[4], bb[4];
#pragma unroll
    for (int j = 0; j < 4; ++j) { g[j] = gp[64 * j]; bb[j] = bp[64 * j]; }
    for (int m = gw; m < MTOK; m += NGW) {
        const GAS f32x4* yr = (const GAS f32x4*)(Y + (size_t)m * DM) + F.lane;
        f32x4 v[4]; float s = 0.f;
#pragma unroll
        for (int j = 0; j < 4; ++j) { v[j] = yr[64 * j]; s += (v[j].x + v[j].y) + (v[j].z + v[j].w); }
        const float mean = wave_sum(s) * (1.f / DM); float s2 = 0.f;
#pragma unroll
        for (int j = 0; j < 4; ++j) { v[j] = v[j] - mean; s2 += (v[j].x * v[j].x + v[j].y * v[j].y) + (v[j].z * v[j].z + v[j].w * v[j].w); }
        const float rstd = 1.f / sqrtf(wave_sum(s2) * (1.f / DM) + LN_EPS);
        float* dst = last ? (m < MP ? F.out + OY_P + (size_t)m * DM : F.out + OY_S + (size_t)(m - MP) * DM) : X + (size_t)m * DM;
        GAS f32x4* xo = (GAS f32x4*)dst + F.lane; GAS unsigned long long* o8 = (GAS unsigned long long*)(XB + (size_t)m * DM) + F.lane;
#pragma unroll
        for (int j = 0; j < 4; ++j) { const f32x4 o = v[j] * rstd * g[j] + bb[j]; xo[64 * j] = o; if (!last) o8[64 * j] = (unsigned long long)pk2(o.x, o.y) | ((unsigned long long)pk2(o.z, o.w) << 32); }
    }
}
__device__ __forceinline__ void conv_phase(const Frame& F0, const Args& A, int e) {
    Frame F = F0; asm volatile("" : "+v"(F.tid)); asm volatile("" : "+s"(F.vcu)); F.lane = F.tid & 63; F.wave = __builtin_amdgcn_readfirstlane(F.tid >> 6);
    const bf16* H = (const bf16*)(F.ws + WS_H); bf16* AO = (bf16*)(F.ws + WS_AO);
    LAS unsigned* ub = (LAS unsigned*)F.lds;
    LAS float* red = (LAS float*)(F.lds + 64 * 512 * 4);
    const int tid = F.tid, ch = 2 * tid;
    typedef float f32x2 __attribute__((ext_vector_type(2)));
    const float* cw = A.in[8] + (size_t)e * 31 * DM; f32x2 w[31];
#pragma unroll
    for (int j = 0; j < 31; ++j) w[j] = *(const GAS f32x2*)(cw + (size_t)j * DM + ch);
    const f32x2 cb = *(const GAS f32x2*)(A.in[9] + (size_t)e * DM + ch), lg = *(const GAS f32x2*)(A.in[10] + (size_t)e * DM + ch), lb = *(const GAS f32x2*)(A.in[11] + (size_t)e * DM + ch);
    for (int unit = F.vcu; unit < 264; unit += F.G) {
        const bool samp = unit >= 256; const int b = samp ? unit - 256 : unit >> 6, t0 = samp ? 0 : (unit & 63) * 64;
        const size_t grow0 = samp ? (size_t)MP + b * SSEQ : (size_t)b * SEQ;
        const int T = samp ? SSEQ : SEQ;
        int gi = 0;
        for (int hf = 0; hf < (samp ? 1 : 2); ++hf) {
            const int tb = hf == 0 ? t0 - 32 : t0 + 32, nb_ = hf == 0 ? 8 : 4;
            for (int bt = 0; bt < nb_; ++bt) {
                unsigned av[8], gv[8];
#pragma unroll
                for (int r = 0; r < 8; ++r) { const int t = tb + bt * 8 + r; av[r] = 0u; gv[r] = 0u;
                    if (t >= 0 && t < T) { const bf16* hp = H + (grow0 + t) * IN_EVEN; av[r] = *(const GAS unsigned*)(hp + ch); gv[r] = *(const GAS unsigned*)(hp + 1024 + ch); } }
#pragma unroll
                for (int r = 0; r < 8; ++r) { const int t = tb + bt * 8 + r; float u0 = 0.f, u1 = 0.f;
                    if (t >= 0 && t < T) {
                        u0 = bflo(av[r]) * sigmoidf_(bflo(gv[r])); u1 = bfhi(av[r]) * sigmoidf_(bfhi(gv[r]));
                        if (!samp && t >= SEQ - 30) *(GAS f32x2*)(F.out + OCONV_P + ((size_t)(e * NB + b) * 30 + (t - (SEQ - 30))) * DM + ch) = (f32x2){u0, u1};
                        if (samp) *(GAS f32x2*)(F.out + OCONV_S + ((size_t)(e * SB + b) * 30 + (14 + t)) * DM + ch) = (f32x2){u0, u1};
                    } else if (samp && t < 0 && t >= -30) {
                        const f32x2 s = *(const GAS f32x2*)(A.in[2] + ((size_t)(e * SB + b) * 30 + (30 + t)) * DM + ch); u0 = s.x; u1 = s.y;
                        if (30 + t >= 16) *(GAS f32x2*)(F.out + OCONV_S + ((size_t)(e * SB + b) * 30 + (30 + t - 16)) * DM + ch) = s;
                    }
                    ub[((t - t0 + 32) & 63) * 512 + tid] = cvtpk(u0, u1); }
            }
            LDS_BAR();
            const int ngrp = samp ? 4 : 8;
            for (int tg = 0; tg < ngrp; ++tg, ++gi) {
                unsigned zz[4];
#pragma unroll
                for (int tt = 0; tt < 4; ++tt) zz[tt] = *(const GAS unsigned*)(H + (grow0 + t0 + 32 * hf + 4 * tg + tt) * IN_EVEN + 2048 + ch);
                f32x2 acc[4];
#pragma unroll
                for (int tt = 0; tt < 4; ++tt) acc[tt] = cb;
#pragma unroll
                for (int jj = 0; jj < 34; ++jj) { const unsigned pv = ub[((32 * hf + 4 * tg + jj + 2) & 63) * 512 + tid]; const f32x2 val = {bflo(pv), bfhi(pv)};
#pragma unroll
                    for (int tt = 0; tt < 4; ++tt) { if (jj - tt >= 0 && jj - tt <= 30) acc[tt] += w[jj - tt] * val; } }
                float st[8];
#pragma unroll
                for (int tt = 0; tt < 4; ++tt) { st[2 * tt] = acc[tt].x + acc[tt].y; st[2 * tt + 1] = acc[tt].x * acc[tt].x + acc[tt].y * acc[tt].y; }
#pragma unroll
                for (int i = 0; i < 8; ++i) st[i] = wave_sum(st[i]);
                LAS float* rb = red + (gi & 1) * 64;
                if (F.lane < 8) { float v = st[0];
#pragma unroll
                    for (int i = 1; i < 8; ++i) v = (F.lane == i) ? st[i] : v;
                    rb[F.wave * 8 + F.lane] = v; }
                LDS_BAR();
#pragma unroll
                for (int tt = 0; tt < 4; ++tt) {
                    float s1 = 0.f, s2 = 0.f;
#pragma unroll
                    for (int wv = 0; wv < 8; ++wv) { s1 += rb[wv * 8 + 2 * tt]; s2 += rb[wv * 8 + 2 * tt + 1]; }
                    const float mean = s1 * (1.f / DM), var = fmaxf(s2 * (1.f / DM) - mean * mean, 0.f), rstd = 1.f / sqrtf(var + LN_EPS);
                    const size_t row = grow0 + t0 + 32 * hf + 4 * tg + tt;
                    const float c0 = (acc[tt].x - mean) * rstd * lg.x + lb.x, c1 = (acc[tt].y - mean) * rstd * lg.y + lb.y;
                    *(GAS unsigned*)(AO + row * 2048 + ch) = cvtpk(siluf_(c0) * siluf_(bflo(zz[tt])), siluf_(c1) * siluf_(bfhi(zz[tt])));
                }
            }
            LDS_BAR();
        }
    }
}
__device__ __forceinline__ void hgrn_prep_phase(const Frame& F0, const Args& A, int e) {
    Frame F = F0; asm volatile("" : "+v"(F.tid)); asm volatile("" : "+s"(F.vcu)); F.lane = F.tid & 63; F.wave = __builtin_amdgcn_readfirstlane(F.tid >> 6);
    const bf16* H = (const bf16*)(F.ws + WS_H);
    bf16* QH = (bf16*)(F.ws + WS_QH); bf16* KT = (bf16*)(F.ws + WS_KT); bf16* VT = (bf16*)(F.ws + WS_VT); bf16* OI = (bf16*)(F.ws + WS_OI); float* DD = (float*)(F.ws + WS_DD);
    LAS bf16* Qt = (LAS bf16*)F.lds;
    LAS bf16* Kt = Qt + 64 * 136;
    LAS bf16* Vt = Kt + 64 * 136;
    LAS bf16* At = Vt + 128 * 72;
    LAS float* tot = (LAS float*)(At + 64 * 72);
    const int tid = F.tid, k = tid & 127, rg = tid >> 7, lane = F.lane, w = F.wave, fr = lane & 15, g = lane >> 4;
    for (int unit = F.vcu; unit < NCHUNK * 8; unit += F.G) {
        const int cid = unit >> 3, h = unit & 7; const bool samp = cid >= 256; const int L = samp ? SSEQ : 64;
        const size_t grow0 = samp ? (size_t)MP + (cid - 256) * SSEQ : (size_t)cid * 64;
        const int chn = h * 128 + k;
        float lbv = 0.f; if (e == 1) lbv = sigmoidf_(A.in[12][DM + chn] - A.in[12][chn]);
        float qq[16], gg[16], kk[16], vv[16];
#pragma unroll
        for (int r = 0; r < 16; ++r) { const int row = rg * 16 + r; qq[r] = 0.f; gg[r] = 0.f; kk[r] = 0.f; vv[r] = 0.f;
            if (row < L) { const bf16* hp = H + (grow0 + row) * IN_EVEN + chn;
                const float q = bf2f(hp[3072]), fr_ = bf2f(hp[4096]); vv[r] = bf2f(hp[5120]);
                const float sg = sigmoidf_(fr_), f = lbv + (1.f - lbv) * sg;
                gg[r] = (lbv > 0.f) ? __logf(f) : -(fmaxf(-fr_, 0.f) + log1pf(__expf(-fabsf(fr_))));
                kk[r] = (1.f - lbv) * sigmoidf_(-fr_); qq[r] = siluf_(q); } }
        float run = 0.f;
#pragma unroll
        for (int r = 0; r < 16; ++r) { run += gg[r]; gg[r] = run; }
        tot[rg * 128 + k] = run;
        LDS_BAR();
        const float t0 = tot[k], t1 = tot[128 + k], t2 = tot[256 + k], t3 = tot[384 + k];
        const float off = (rg > 0 ? t0 : 0.f) + (rg > 1 ? t1 : 0.f) + (rg > 2 ? t2 : 0.f), bm = t0 + t1, blast = (t0 + t1) + (t2 + t3);
        unsigned kw[8], vw[8];
#pragma unroll
        for (int r = 0; r < 16; r += 2) {
            float khv[2];
#pragma unroll
            for (int i = 0; i < 2; ++i) { const int rr = r + i, row = rg * 16 + rr; const float b = off + gg[rr];
                const float qt = qq[rr] * __expf(fminf(b - bm, 80.f)), kt = kk[rr] * __expf(fminf(bm - b, 80.f));
                Qt[row * 136 + k] = (bf16)f2bf(qt); Kt[row * 136 + k] = (bf16)f2bf(kt);
                QH[((size_t)cid * 64 + row) * DM + chn] = (bf16)f2bf(qq[rr] * __expf(b));
                khv[i] = kk[rr] * __expf(blast - b); }
            kw[r >> 1] = pk2(khv[0], khv[1]); vw[r >> 1] = pk2(vv[r], vv[r + 1]);
        }
        { GAS v4u* kd = (GAS v4u*)(KT + (((size_t)cid * 8 + h) * 128 + k) * 64 + rg * 16); kd[0] = (v4u){kw[0], kw[1], kw[2], kw[3]}; kd[1] = (v4u){kw[4], kw[5], kw[6], kw[7]};
          GAS v4u* vd = (GAS v4u*)(VT + (((size_t)cid * 8 + h) * 128 + k) * 64 + rg * 16); vd[0] = (v4u){vw[0], vw[1], vw[2], vw[3]}; vd[1] = (v4u){vw[4], vw[5], vw[6], vw[7]};
          LAS v4u* vl = (LAS v4u*)(Vt + k * 72 + rg * 16); vl[0] = (v4u){vw[0], vw[1], vw[2], vw[3]}; vl[1] = (v4u){vw[4], vw[5], vw[6], vw[7]};
          if (rg == 0) DD[((size_t)cid * 8 + h) * 128 + k] = __expf(blast); }
        LDS_BAR();
        { const int mt = w & 3;
#pragma unroll
          for (int n2 = 0; n2 < 2; ++n2) { const int nt = 2 * (w >> 2) + n2; f32x4 acc = {0.f, 0.f, 0.f, 0.f};
              if (nt <= mt) {
#pragma unroll
                  for (int ks = 0; ks < 4; ++ks) { const bf16x8 a = *(const LAS bf16x8*)(Qt + (16 * mt + fr) * 136 + 32 * ks + 8 * g), bq = *(const LAS bf16x8*)(Kt + (16 * nt + fr) * 136 + 32 * ks + 8 * g);
                      acc = __builtin_amdgcn_mfma_f32_16x16x32_bf16(a, bq, acc, 0, 0, 0); } }
              const int s = 16 * nt + fr;
#pragma unroll
              for (int r = 0; r < 4; ++r) { const int t = 16 * mt + 4 * g + r; At[t * 72 + s] = (bf16)f2bf(s <= t ? acc[r] : 0.f); } } }
        LDS_BAR();
        { const int mt = w & 3; bf16x8 bt[2];
#pragma unroll
          for (int ks = 0; ks < 2; ++ks) bt[ks] = *(const LAS bf16x8*)(At + (16 * mt + fr) * 72 + 32 * ks + 8 * g);
#pragma unroll
          for (int v4 = 0; v4 < 4; ++v4) { const int vt = 4 * (w >> 2) + v4; f32x4 acc = {0.f, 0.f, 0.f, 0.f};
#pragma unroll
              for (int ks = 0; ks < 2; ++ks) { const bf16x8 a = *(const LAS bf16x8*)(Vt + (16 * vt + fr) * 72 + 32 * ks + 8 * g); acc = __builtin_amdgcn_mfma_f32_16x16x32_bf16(a, bt[ks], acc, 0, 0, 0); }
              *(GAS unsigned long long*)(OI + ((size_t)cid * 64 + 16 * mt + fr) * DM + h * 128 + 16 * vt + 4 * g) = (unsigned long long)pk2(acc[0], acc[1]) | ((unsigned long long)pk2(acc[2], acc[3]) << 32); } }
        LDS_BAR();
    }
}
__device__ __forceinline__ void hgrn_scan_phase(const Frame& F0, const Args& A, int e) {
    Frame F = F0; asm volatile("" : "+v"(F.tid)); asm volatile("" : "+s"(F.vcu)); F.lane = F.tid & 63; F.wave = __builtin_amdgcn_readfirstlane(F.tid >> 6);
    const bf16* QH = (const bf16*)(F.ws + WS_QH); const bf16* KT = (const bf16*)(F.ws + WS_KT); const bf16* VT = (const bf16*)(F.ws + WS_VT); bf16* OX = (bf16*)(F.ws + WS_OX); const float* DD = (const float*)(F.ws + WS_DD);
    LAS bf16* ST = (LAS bf16*)F.lds;
    const int lane = F.lane, w = F.wave, fr = lane & 15, g = lane >> 4;
    for (int it = F.vcu; it < 768; it += F.G) {
        const bool samp = it >= 256; const int j = samp ? it - 256 : it; const int b = j >> 6, h = (j >> 3) & 7, vs = j & 7;
        const int nsteps = samp ? 1 : 64, cid0 = samp ? 256 + b : b * 64;
        float* sout = samp ? F.out + OHGRN_S + (((size_t)(e * SB + b) * 8 + h) * 128) * 128 : F.out + OHGRN_P + (((size_t)(e * NB + b) * 8 + h) * 128) * 128;
        f32x4 S = {0.f, 0.f, 0.f, 0.f};
        if (samp) { const float* s0 = A.in[3] + (((size_t)(e * SB + b) * 8 + h) * 128) * 128;
#pragma unroll
            for (int r = 0; r < 4; ++r) S[r] = s0[(size_t)(16 * w + 4 * g + r) * 128 + vs * 16 + fr]; }
        *(LAS unsigned long long*)(ST + fr * 136 + 16 * w + 4 * g) = (unsigned long long)pk2(S[0], S[1]) | ((unsigned long long)pk2(S[2], S[3]) << 32);
        LDS_BAR();
        bf16x8 kA0, kA1, vA0, vA1, qA0, qA1, qA2, qA3, kB0, kB1, vB0, vB1, qB0, qB1, qB2, qB3, kC0, kC1, vC0, vC1, qC0, qC1, qC2, qC3, kD0, kD1, vD0, vD1, qD0, qD1, qD2, qD3; f32x4 dA, dB, dC, dD;
        qA0 = qA1 = qA2 = qA3 = qB0 = qB1 = qB2 = qB3 = qC0 = qC1 = qC2 = qC3 = qD0 = qD1 = qD2 = qD3 = (bf16x8){0, 0, 0, 0, 0, 0, 0, 0};
#define HG_LOAD(X, c) do { const size_t ch_ = (size_t)(cid0 + (c)) * 8 + h; const bf16* kp_ = KT + (ch_ * 128 + 16 * w + fr) * 64 + 8 * g; const bf16* vp_ = VT + (ch_ * 128 + vs * 16 + fr) * 64 + 8 * g; \
            k##X##0 = *(const GAS bf16x8*)(kp_); k##X##1 = *(const GAS bf16x8*)(kp_ + 32); v##X##0 = *(const GAS bf16x8*)(vp_); v##X##1 = *(const GAS bf16x8*)(vp_ + 32); \
            d##X = *(const GAS f32x4*)(DD + ch_ * 128 + 16 * w + 4 * g); \
            if (w < 4) { const bf16* qp_ = QH + ((size_t)(cid0 + (c)) * 64 + 16 * w + fr) * DM + h * 128 + 8 * g; \
                q##X##0 = *(const GAS bf16x8*)(qp_); q##X##1 = *(const GAS bf16x8*)(qp_ + 32); q##X##2 = *(const GAS bf16x8*)(qp_ + 64); q##X##3 = *(const GAS bf16x8*)(qp_ + 96); } } while (0)
#define HG_STEP(X, c) do { if ((c) < nsteps) { const LAS bf16* stc = ST + ((c) & 1) * 16 * 136; \
            if (w < 4) { f32x4 o = {0.f, 0.f, 0.f, 0.f}; \
                o = __builtin_amdgcn_mfma_f32_16x16x32_bf16(*(const LAS bf16x8*)(stc + fr * 136 + 0 + 8 * g), q##X##0, o, 0, 0, 0); \
                o = __builtin_amdgcn_mfma_f32_16x16x32_bf16(*(const LAS bf16x8*)(stc + fr * 136 + 32 + 8 * g), q##X##1, o, 0, 0, 0); \
                o = __builtin_amdgcn_mfma_f32_16x16x32_bf16(*(const LAS bf16x8*)(stc + fr * 136 + 64 + 8 * g), q##X##2, o, 0, 0, 0); \
                o = __builtin_amdgcn_mfma_f32_16x16x32_bf16(*(const LAS bf16x8*)(stc + fr * 136 + 96 + 8 * g), q##X##3, o, 0, 0, 0); \
                *(GAS unsigned long long*)(OX + ((size_t)(cid0 + (c)) * 64 + 16 * w + fr) * DM + h * 128 + vs * 16 + 4 * g) = (unsigned long long)pk2(o[0], o[1]) | ((unsigned long long)pk2(o[2], o[3]) << 32); } \
            S = S * d##X; \
            S = __builtin_amdgcn_mfma_f32_16x16x32_bf16(k##X##0, v##X##0, S, 0, 0, 0); \
            S = __builtin_amdgcn_mfma_f32_16x16x32_bf16(k##X##1, v##X##1, S, 0, 0, 0); \
            *(LAS unsigned long long*)(ST + (((c) + 1) & 1) * 16 * 136 + fr * 136 + 16 * w + 4 * g) = (unsigned long long)pk2(S[0], S[1]) | ((unsigned long long)pk2(S[2], S[3]) << 32); \
            if ((c) + 4 < nsteps) HG_LOAD(X, (c) + 4); \
            LDS_BAR(); } } while (0)
        HG_LOAD(A, 0); if (1 < nsteps) HG_LOAD(B, 1); if (2 < nsteps) HG_LOAD(C, 2); if (3 < nsteps) HG_LOAD(D, 3);
        for (int c = 0; c < nsteps; c += 4) { HG_STEP(A, c); HG_STEP(B, c + 1); HG_STEP(C, c + 2); HG_STEP(D, c + 3); }
#undef HG_STEP
#undef HG_LOAD
#pragma unroll
        for (int r = 0; r < 4; ++r) sout[(size_t)(16 * w + 4 * g + r) * 128 + vs * 16 + fr] = S[r];
        LDS_BAR();
    }
}
__device__ __forceinline__ void hgrn_combine_phase(const Frame& F0, const Args& A, int e) {
    Frame F = F0; asm volatile("" : "+v"(F.tid)); asm volatile("" : "+s"(F.vcu)); F.lane = F.tid & 63; F.wave = __builtin_amdgcn_readfirstlane(F.tid >> 6);
    const bf16* H = (const bf16*)(F.ws + WS_H); const bf16* OI = (const bf16*)(F.ws + WS_OI); const bf16* OX = (const bf16*)(F.ws + WS_OX); bf16* AO = (bf16*)(F.ws + WS_AO);
    const float* hg = A.in[13] + (size_t)e * 128;
    const size_t gt = (size_t)F.vcu * 512 + F.tid, NT = (size_t)F.G * 512;
    for (size_t i = gt; i < (size_t)MTOK * 128; i += NT) {
        const int row = (int)(i >> 7), seg = (int)(i & 127);
        const size_t crow = row < MP ? (size_t)row : (size_t)(256 + ((row - MP) >> 4)) * 64 + ((row - MP) & 15);
        const v4u a = *(const GAS v4u*)(OI + crow * DM + seg * 8), bq = *(const GAS v4u*)(OX + crow * DM + seg * 8), z = *(const GAS v4u*)(H + (size_t)row * IN_EVEN + 6144 + seg * 8);
        float o[8]; float ss = 0.f;
#pragma unroll
        for (int j = 0; j < 4; ++j) { o[2 * j] = bflo(a[j]) + bflo(bq[j]); o[2 * j + 1] = bfhi(a[j]) + bfhi(bq[j]); ss += o[2 * j] * o[2 * j] + o[2 * j + 1] * o[2 * j + 1]; }
        ss += __shfl_xor(ss, 1); ss += __shfl_xor(ss, 2); ss += __shfl_xor(ss, 4); ss += __shfl_xor(ss, 8);
        const float rs = 1.f / sqrtf(ss * (1.f / 128.f) + LN_EPS);
        const GAS f32x4* gp = (const GAS f32x4*)(hg + (seg & 15) * 8); const f32x4 g0 = gp[0], g1 = gp[1];
        const float gv[8] = {g0.x, g0.y, g0.z, g0.w, g1.x, g1.y, g1.z, g1.w};
        v4u r;
#pragma unroll
        for (int j = 0; j < 4; ++j) r[j] = pk2(o[2 * j] * rs * gv[2 * j] * siluf_(bflo(z[j])), o[2 * j + 1] * rs * gv[2 * j + 1] * siluf_(bfhi(z[j])));
        *(GAS v4u*)(AO + (size_t)row * 2048 + 1024 + seg * 8) = r;
    }
}
namespace att {
using f32x16 = __attribute__((ext_vector_type(16))) float;
using s16x4  = __attribute__((ext_vector_type(4))) short;
constexpr int LDH = 8192, KVBLK = 64;
constexpr float SCALE = 0.125f, THR = 8.f;
constexpr int SHM_V = 16384, SHM_K = 16384, LDS_T = 0, LDS_WS = 69632, T_STRIDE = 132;
#define KSWZ(row, colB) ((row) * 256 + ((colB) ^ (((row) & 7) << 4)))
#define SBAR() __builtin_amdgcn_sched_barrier(0)
__device__ __forceinline__ int crow(int r, int hi) { return (r & 3) + 8 * (r >> 2) + 4 * hi; }
__device__ __forceinline__ void partialSM(f32x16& p0, f32x16& p1, float& m_reg, float& mn, float& alpha) {
  constexpr float C = SCALE * 1.4426950408889634f;
  float pmax = p0[0];
#pragma unroll
  for (int r = 1; r < 16; ++r) pmax = fmaxf(pmax, p0[r]);
#pragma unroll
  for (int r = 0; r < 16; ++r) pmax = fmaxf(pmax, p1[r]);
  { auto rr = __builtin_amdgcn_permlane32_swap(__float_as_uint(pmax), __float_as_uint(pmax), false, false);
    pmax = fmaxf(__uint_as_float(rr[0]), __uint_as_float(rr[1])); }
  if (__builtin_expect(__all(pmax - m_reg <= THR / SCALE), 1)) { mn = m_reg; alpha = 1.f; }
  else { mn = fmaxf(m_reg, pmax); alpha = __builtin_amdgcn_exp2f((m_reg - mn) * C); m_reg = mn; }
  const float mnC = -mn * C;
#pragma unroll
  for (int r = 0; r < 16; ++r) p0[r] = fmaf(p0[r], C, mnC);
#pragma unroll
  for (int r = 0; r < 16; ++r) p1[r] = fmaf(p1[r], C, mnC);
#pragma unroll
  for (int r = 0; r < 16; ++r) p0[r] = __builtin_amdgcn_exp2f(p0[r]);
}
__device__ __forceinline__ void finishSM(f32x16& p0, f32x16& p1, float alpha, float& l_reg, bf16x8& pa0, bf16x8& pa1, bf16x8& pa2, bf16x8& pa3) {
#pragma unroll
  for (int r = 0; r < 16; ++r) p1[r] = __builtin_amdgcn_exp2f(p1[r]);
  float ps = 0;
#pragma unroll
  for (int r = 0; r < 16; ++r) ps += p0[r];
#pragma unroll
  for (int r = 0; r < 16; ++r) ps += p1[r];
  { auto rr = __builtin_amdgcn_permlane32_swap(__float_as_uint(ps), __float_as_uint(ps), false, false);
    ps = __uint_as_float(rr[0]) + __uint_as_float(rr[1]); }
  l_reg = l_reg * alpha + ps;
#define PK4(P, BASE, OUT) do { unsigned a0 = cvtpk(P[BASE + 0], P[BASE + 1]), a1 = cvtpk(P[BASE + 2], P[BASE + 3]);   \
    unsigned b0 = cvtpk(P[BASE + 4], P[BASE + 5]), b1 = cvtpk(P[BASE + 6], P[BASE + 7]);                              \
    auto r0 = __builtin_amdgcn_permlane32_swap(a0, b0, false, false); auto r1 = __builtin_amdgcn_permlane32_swap(a1, b1, false, false); \
    v4u w_ = {r0[0], r1[0], r0[1], r1[1]}; OUT = __builtin_bit_cast(bf16x8, w_); } while (0)
  PK4(p0, 0, pa0); PK4(p0, 8, pa1); PK4(p1, 0, pa2); PK4(p1, 8, pa3);
#undef PK4
}
__device__ __forceinline__ void qkt(f32x16& p0, f32x16& p1, const LAS char* Ks, const bf16x8* qr, int r32, int hi, int cbase) {
  p0 = f32x16{}; p1 = f32x16{};
#pragma unroll
  for (int d0 = 0; d0 < 4; ++d0) { const int cb = cbase + (d0 * 16 + hi * 8) * 2;
    const bf16x8 b0 = *(const LAS bf16x8*)(Ks + KSWZ(r32, cb));
    const bf16x8 b1 = *(const LAS bf16x8*)(Ks + KSWZ(32 + r32, cb));
    p0 = __builtin_amdgcn_mfma_f32_32x32x16_bf16(b0, qr[d0], p0, 0, 0, 0);
    p1 = __builtin_amdgcn_mfma_f32_32x32x16_bf16(b1, qr[d0], p1, 0, 0, 0); }
}
__device__ __forceinline__ int v_st(int k, int c) { const int kk = (k & ~0xC) | ((k & 4) << 1) | ((k & 8) >> 1); return ((kk >> 3) * 4 + (c >> 5)) * 512 + ((kk & 7) * 32 + (c & 31)) * 2; }
__device__ __forceinline__ int v_rd_base(int lane) { return ((lane & 3) << 3) | (((lane >> 2) & 3) << 6) | (((lane >> 4) & 1) << 5) | (((lane >> 5) & 1) << 8); }
constexpr int v_rd_off(int d0, int ks, int half) { return d0 * 512 + ks * 4096 + half * 2048; }
template <int OFF> __device__ __forceinline__ s16x4 tr_read(int vb) {
  s16x4 r; asm volatile("ds_read_b64_tr_b16 %0, %1 offset:%2" : "=&v"(r) : "v"(vb), "i"(OFF) : "memory"); return r;
}
template <int D0> __device__ __forceinline__ void pv_one(f32x16& od, int vb, bf16x8 pa0, bf16x8 pa1, bf16x8 pa2, bf16x8 pa3) {
  const s16x4 l0 = tr_read<v_rd_off(D0, 0, 0)>(vb), h0 = tr_read<v_rd_off(D0, 0, 1)>(vb), l1 = tr_read<v_rd_off(D0, 1, 0)>(vb), h1 = tr_read<v_rd_off(D0, 1, 1)>(vb);
  const s16x4 l2 = tr_read<v_rd_off(D0, 2, 0)>(vb), h2 = tr_read<v_rd_off(D0, 2, 1)>(vb), l3 = tr_read<v_rd_off(D0, 3, 0)>(vb), h3 = tr_read<v_rd_off(D0, 3, 1)>(vb);
  asm volatile("s_waitcnt lgkmcnt(0)" ::: "memory"); SBAR();
#define PK(L, H) (bf16x8){L[0], L[1], L[2], L[3], H[0], H[1], H[2], H[3]}
  od = __builtin_amdgcn_mfma_f32_32x32x16_bf16(pa0, PK(l0, h0), od, 0, 0, 0);
  od = __builtin_amdgcn_mfma_f32_32x32x16_bf16(pa1, PK(l1, h1), od, 0, 0, 0);
  od = __builtin_amdgcn_mfma_f32_32x32x16_bf16(pa2, PK(l2, h2), od, 0, 0, 0);
  od = __builtin_amdgcn_mfma_f32_32x32x16_bf16(pa3, PK(l3, h3), od, 0, 0, 0);
#undef PK
}
__device__ __forceinline__ void pv_d0(f32x16* o, int vb, bf16x8 pa0, bf16x8 pa1, bf16x8 pa2, bf16x8 pa3) {
  pv_one<0>(o[0], vb, pa0, pa1, pa2, pa3); pv_one<1>(o[1], vb, pa0, pa1, pa2, pa3); pv_one<2>(o[2], vb, pa0, pa1, pa2, pa3); pv_one<3>(o[3], vb, pa0, pa1, pa2, pa3);
}
__device__ __forceinline__ void attn_unit(const bf16* __restrict__ H, bf16* __restrict__ AO, const float* __restrict__ subg, int b, int h, int qb, float lam, float post, LAS char* lds) {
  int tid_ = threadIdx.x; asm volatile("" : "+v"(tid_)); const int tid = tid_, wid = __builtin_amdgcn_readfirstlane(tid >> 6), lane = tid & 63, r32 = lane & 31, hi = lane >> 5;
  const int map = wid >> 2, wq = wid & 3;
  LAS char* V_lds = lds; LAS char* K_lds = lds + 2 * SHM_V;
  LAS float* ws = (LAS float*)(lds + LDS_WS) + wid * 64; LAS float* li_l = ws; LAS float* al_l = ws + 32;
  const size_t rowbase = (size_t)b * SEQ; const int q0 = qb * 128;
  const bf16* Kh = H + rowbase * LDH + 2048 + h * 128; const bf16* Vh = H + rowbase * LDH + 4096 + h * 128;
  float m_reg = -1e30f, l_reg = 0; f32x16 o[4] = {}; bf16x8 qr[4];
  const bf16* Qw = H + (rowbase + q0 + wq * 32 + r32) * LDH + h * 128 + map * 64 + hi * 8;
#pragma unroll
  for (int d0 = 0; d0 < 4; ++d0) qr[d0] = *(const GAS bf16x8*)(Qw + d0 * 16);
  const int sr = tid >> 4, sc = (tid & 15) * 8, vst0 = v_st(sr, sc), vst1 = v_st(32 + sr, sc);
  const int vb0 = (int)(unsigned)(uintptr_t)V_lds + v_rd_base(lane);
  const int cbase = map * 128;
  struct { bf16x8 vs0, vs1, ks0, ks1; } sr_[1];
#define SLOAD(i, k0) do { sr_[i].vs0 = *(const GAS bf16x8*)(&Vh[(size_t)((k0) + sr) * LDH + sc]); sr_[i].vs1 = *(const GAS bf16x8*)(&Vh[(size_t)((k0) + 32 + sr) * LDH + sc]); \
    sr_[i].ks0 = *(const GAS bf16x8*)(&Kh[(size_t)((k0) + sr) * LDH + sc]); sr_[i].ks1 = *(const GAS bf16x8*)(&Kh[(size_t)((k0) + 32 + sr) * LDH + sc]); } while (0)
#define SWRITE(bq, i) do { *(LAS bf16x8*)(V_lds + (bq) * SHM_V + vst0) = sr_[i].vs0; *(LAS bf16x8*)(V_lds + (bq) * SHM_V + vst1) = sr_[i].vs1; const int kc = sc * 2; \
    *(LAS bf16x8*)(K_lds + (bq) * SHM_K + KSWZ(sr, kc)) = sr_[i].ks0; *(LAS bf16x8*)(K_lds + (bq) * SHM_K + KSWZ(32 + sr, kc)) = sr_[i].ks1; } while (0)
#define SWAIT() asm volatile("s_waitcnt vmcnt(0)" ::: "memory")
#define RESC(a) do { if (__any((a) < 1.f)) { if (hi == 0) al_l[r32] = (a); asm volatile("s_waitcnt lgkmcnt(0)" ::: "memory"); \
    _Pragma("unroll") for (int d = 0; d < 4; ++d) _Pragma("unroll") for (int r = 0; r < 16; ++r) o[d][r] *= al_l[crow(r, hi)]; } } while (0)
  f32x16 pA0, pA1, pB0, pB1; float mnA, mnB, alA, alB; bf16x8 pa0, pa1, pa2, pa3;
  const int NT = 2 * qb + 2; const bool full = wq >= 2;
  constexpr int SE = 0, SO = 0;
  SLOAD(SE, 0); asm volatile("s_waitcnt vmcnt(0)" ::: "memory"); SWRITE(0, SE); __syncthreads();
  qkt(pA0, pA1, K_lds, qr, r32, hi, cbase); partialSM(pA0, pA1, m_reg, mnA, alA);
  SLOAD(SO, KVBLK);
  SWAIT(); SWRITE(1, SO); __syncthreads();
  for (int j = 1; j + 1 < NT; j += 2) {
    SBAR(); qkt(pB0, pB1, K_lds + SHM_K, qr, r32, hi, cbase);
    finishSM(pA0, pA1, alA, l_reg, pa0, pa1, pa2, pa3); SBAR();
    SLOAD(SO, (j + 1) * KVBLK); SBAR();
    pv_d0(o, vb0, pa0, pa1, pa2, pa3); partialSM(pB0, pB1, m_reg, mnB, alB);
    __syncthreads(); SWAIT(); SWRITE(0, SE);
    RESC(alB); __syncthreads();
    SBAR(); qkt(pA0, pA1, K_lds, qr, r32, hi, cbase);
    finishSM(pB0, pB1, alB, l_reg, pa0, pa1, pa2, pa3); SBAR();
    SLOAD(SE, (j + 2) * KVBLK); SBAR();
    pv_d0(o, vb0 + SHM_V, pa0, pa1, pa2, pa3); partialSM(pA0, pA1, m_reg, mnA, alA);
    __syncthreads(); SWAIT(); SWRITE(1, SO);
    RESC(alA); __syncthreads();
  }
  SBAR(); if (full) qkt(pB0, pB1, K_lds + SHM_K, qr, r32, hi, cbase);
  finishSM(pA0, pA1, alA, l_reg, pa0, pa1, pa2, pa3); SBAR();
  pv_d0(o, vb0, pa0, pa1, pa2, pa3);
  if (full) { partialSM(pB0, pB1, m_reg, mnB, alB); RESC(alB);
    finishSM(pB0, pB1, alB, l_reg, pa0, pa1, pa2, pa3); SBAR();
    pv_d0(o, vb0 + SHM_V, pa0, pa1, pa2, pa3); }
  if (hi == 0) li_l[r32] = l_reg; asm volatile("s_waitcnt lgkmcnt(0)" ::: "memory");
  float rli[16];
#pragma unroll
  for (int r = 0; r < 16; ++r) rli[r] = __builtin_amdgcn_rcpf(li_l[crow(r, hi)]);
  __syncthreads();
  LAS float* T = (LAS float*)(lds + LDS_T);
  if (map == 1) {
#pragma unroll
    for (int r = 0; r < 16; ++r)
#pragma unroll
      for (int d0 = 0; d0 < 4; ++d0) T[(wq * 32 + crow(r, hi)) * T_STRIDE + d0 * 32 + r32] = lam * o[d0][r] * rli[r];
  }
  __syncthreads();
  if (map == 0) {
#pragma unroll
    for (int r = 0; r < 16; ++r)
#pragma unroll
      for (int d0 = 0; d0 < 4; ++d0) { LAS float* p = T + (wq * 32 + crow(r, hi)) * T_STRIDE + d0 * 32 + r32; *p = o[d0][r] * rli[r] - *p; }
  }
  __syncthreads();
  { const int row = tid >> 2, seg = tid & 3; const LAS f32x4* tp = (const LAS f32x4*)(T + row * T_STRIDE + seg * 32);
    f32x4 x[8]; float ss = 0.f;
#pragma unroll
    for (int i = 0; i < 8; ++i) { x[i] = tp[i]; ss += (x[i].x * x[i].x + x[i].y * x[i].y) + (x[i].z * x[i].z + x[i].w * x[i].w); }
    ss += __shfl_xor(ss, 1); ss += __shfl_xor(ss, 2);
    const float rs = post / sqrtf(ss * (1.f / 128.f) + LN_EPS);
    const size_t grow = rowbase + q0 + row;
    const GAS v4u* zp = (const GAS v4u*)(H + grow * LDH + 6144 + h * 128 + seg * 32); const GAS f32x4* gp = (const GAS f32x4*)(subg + seg * 32);
    GAS v4u* op = (GAS v4u*)(AO + grow * 2048 + h * 128 + seg * 32);
#pragma unroll
    for (int i = 0; i < 4; ++i) { const v4u z = zp[i]; const f32x4 g0 = gp[2 * i], g1 = gp[2 * i + 1]; const f32x4 a = x[2 * i] * rs * g0, c = x[2 * i + 1] * rs * g1;
      v4u r; r.x = pk2(a.x * bflo(z.x), a.y * bfhi(z.x)); r.y = pk2(a.z * bflo(z.y), a.w * bfhi(z.y)); r.z = pk2(c.x * bflo(z.z), c.y * bfhi(z.z)); r.w = pk2(c.z * bflo(z.w), c.w * bfhi(z.w));
      op[i] = r; } }
  __syncthreads();
#undef SLOAD
#undef SWRITE
#undef SWAIT
#undef RESC
}
#undef KSWZ
#undef SBAR
}

constexpr int SA_NSPLIT = 2, SA_NPART = SA_NSPLIT * 4;
constexpr int SA_KSTR = 136, SA_VSTR = 144;
constexpr int SA_PART_FLOATS = 2048 + 32;
__device__ __forceinline__ void sattn_phase(const Frame& F0, const Args& A, int o_idx) {
    Frame F = F0; asm volatile("" : "+v"(F.tid)); asm volatile("" : "+s"(F.vcu)); F.lane = F.tid & 63; F.wave = __builtin_amdgcn_readfirstlane(F.tid >> 6);
    const bf16* H = (const bf16*)(F.ws + WS_H); float* PART = (float*)(F.ws + WS_PART);
    LAS bf16* Ks = (LAS bf16*)F.lds;
    LAS bf16* Vs = Ks + 128 * SA_KSTR;
    const int tid = F.tid, lane = F.lane, w = F.wave, fr = lane & 15, g = lane >> 4, map = w >> 2, kq = w & 3;
    constexpr float C = 0.125f * 1.4426950408889634f;
    const int NKEY = PAST + SSEQ, NTILE = (NKEY + 127) / 128;
    for (int it = F.vcu; it < SB * 16 * SA_NSPLIT; it += F.G) {
        const int split = it % SA_NSPLIT, bh = it / SA_NSPLIT, b = bh >> 4, h = bh & 15;
        const int tile_lo = split * ((NTILE + SA_NSPLIT - 1) / SA_NSPLIT), tile_hi = min(NTILE, tile_lo + (NTILE + SA_NSPLIT - 1) / SA_NSPLIT);
        const float* Kc = A.in[4] + ((size_t)(o_idx * SB + b) * PAST) * 2048 + h * 128; const float* Vc = A.in[5] + ((size_t)(o_idx * SB + b) * PAST) * 2048 + h * 128;
        const float* Kn = F.out + OK_S + ((size_t)(o_idx * SB + b) * SSEQ) * 2048 + h * 128; const float* Vn = F.out + OV_S + ((size_t)(o_idx * SB + b) * SSEQ) * 2048 + h * 128;
        bf16x8 qf[2];
#pragma unroll
        for (int ds = 0; ds < 2; ++ds) qf[ds] = *(const GAS bf16x8*)(H + ((size_t)MP + b * SSEQ + fr) * 8192 + h * 128 + map * 64 + 32 * ds + 8 * g);
        float m_run = -1e30f, l_run = 0.f; f32x4 O[8];
#pragma unroll
        for (int vt = 0; vt < 8; ++vt) O[vt] = (f32x4){0.f, 0.f, 0.f, 0.f};
        const int lkey = tid >> 2, lq = tid & 3;
        f32x4 kreg[8], vreg[8];
#define SA_LOAD(t) do { const int key_ = (t) * 128 + lkey; \
            if (key_ < NKEY) { const float* kp_ = key_ < PAST ? Kc + (size_t)key_ * 2048 : Kn + (size_t)(key_ - PAST) * 2048; const float* vp_ = key_ < PAST ? Vc + (size_t)key_ * 2048 : Vn + (size_t)(key_ - PAST) * 2048; \
                _Pragma("unroll") for (int i = 0; i < 8; ++i) { kreg[i] = *(const GAS f32x4*)(kp_ + lq * 32 + 4 * i); vreg[i] = *(const GAS f32x4*)(vp_ + lq * 32 + 4 * i); } } \
            else { _Pragma("unroll") for (int i = 0; i < 8; ++i) { kreg[i] = (f32x4){0.f, 0.f, 0.f, 0.f}; vreg[i] = (f32x4){0.f, 0.f, 0.f, 0.f}; } } } while (0)
        SA_LOAD(tile_lo);
        for (int t = tile_lo; t < tile_hi; ++t) {
#pragma unroll
            for (int i = 0; i < 4; ++i) {
                *(LAS v4u*)(Ks + lkey * SA_KSTR + lq * 32 + 8 * i) = (v4u){cvtpk(kreg[2 * i].x, kreg[2 * i].y), cvtpk(kreg[2 * i].z, kreg[2 * i].w), cvtpk(kreg[2 * i + 1].x, kreg[2 * i + 1].y), cvtpk(kreg[2 * i + 1].z, kreg[2 * i + 1].w)};
                *(LAS v4u*)(Vs + lkey * SA_VSTR + lq * 32 + 8 * i) = (v4u){cvtpk(vreg[2 * i].x, vreg[2 * i].y), cvtpk(vreg[2 * i].z, vreg[2 * i].w), cvtpk(vreg[2 * i + 1].x, vreg[2 * i + 1].y), cvtpk(vreg[2 * i + 1].z, vreg[2 * i + 1].w)}; }
            LDS_BAR();
            if (t + 1 < tile_hi) SA_LOAD(t + 1);
            const int kb = kq * 32; f32x4 sA = {0.f, 0.f, 0.f, 0.f}, sB = {0.f, 0.f, 0.f, 0.f};
#pragma unroll
            for (int ds = 0; ds < 2; ++ds) {
                const bf16x8 ka = *(const LAS bf16x8*)(Ks + (kb + fr) * SA_KSTR + map * 64 + 32 * ds + 8 * g), kb2 = *(const LAS bf16x8*)(Ks + (kb + 16 + fr) * SA_KSTR + map * 64 + 32 * ds + 8 * g);
                sA = __builtin_amdgcn_mfma_f32_16x16x32_bf16(ka, qf[ds], sA, 0, 0, 0); sB = __builtin_amdgcn_mfma_f32_16x16x32_bf16(kb2, qf[ds], sB, 0, 0, 0); }
            const int key0 = t * 128 + kb + 4 * g;
            float sv[8]; float mx = -1e30f;
#pragma unroll
            for (int r = 0; r < 4; ++r) { sv[r] = (key0 + r < NKEY) ? sA[r] * C : -1e30f; sv[4 + r] = (key0 + 16 + r < NKEY) ? sB[r] * C : -1e30f; mx = fmaxf(mx, fmaxf(sv[r], sv[4 + r])); }
            mx = fmaxf(mx, __shfl_xor(mx, 16)); mx = fmaxf(mx, __shfl_xor(mx, 32));
            const float mn = fmaxf(m_run, mx), al = __builtin_amdgcn_exp2f(m_run - mn); m_run = mn;
            float ps = 0.f; float p[8];
#pragma unroll
            for (int r = 0; r < 8; ++r) { p[r] = __builtin_amdgcn_exp2f(sv[r] - mn); ps += p[r]; }
            l_run = l_run * al + ps;
            const v4u pw = {cvtpk(p[0], p[1]), cvtpk(p[2], p[3]), cvtpk(p[4], p[5]), cvtpk(p[6], p[7])}; const bf16x8 pb = __builtin_bit_cast(bf16x8, pw);
            const int vaddr = (int)(unsigned)(uintptr_t)(Vs + (kb + 4 * g + ((lane & 15) >> 2)) * SA_VSTR + 4 * (lane & 3));
#pragma unroll
            for (int vt = 0; vt < 8; ++vt) {
                att::s16x4 lo, hi2;
                asm volatile("ds_read_b64_tr_b16 %0, %1 offset:%2" : "=&v"(lo) : "v"(vaddr), "i"(vt * 32) : "memory");
                asm volatile("ds_read_b64_tr_b16 %0, %1 offset:%2" : "=&v"(hi2) : "v"(vaddr), "i"(vt * 32 + 16 * SA_VSTR * 2) : "memory");
                asm volatile("s_waitcnt lgkmcnt(0)" ::: "memory"); __builtin_amdgcn_sched_barrier(0);
                const bf16x8 va = {lo[0], lo[1], lo[2], lo[3], hi2[0], hi2[1], hi2[2], hi2[3]};
                O[vt] = O[vt] * al;
                O[vt] = __builtin_amdgcn_mfma_f32_16x16x32_bf16(va, pb, O[vt], 0, 0, 0);
            }
            LDS_BAR();
        }
#undef SA_LOAD
        l_run += __shfl_xor(l_run, 16); l_run += __shfl_xor(l_run, 32);
        float* pp = PART + ((size_t)((bh * 2 + map) * SA_NPART + split * 4 + kq)) * SA_PART_FLOATS;
#pragma unroll
        for (int vt = 0; vt < 8; ++vt)
#pragma unroll
            for (int r = 0; r < 4; ++r) pp[(16 * vt + 4 * g + r) * 16 + fr] = O[vt][r];
        if (g == 0) { pp[2048 + fr] = m_run; pp[2048 + 16 + fr] = l_run; }
    }
}
__device__ __forceinline__ void sattn_combine_phase(const Frame& F0, const Args& A, int o_idx, float lam, float post) {
    Frame F = F0; asm volatile("" : "+v"(F.tid)); asm volatile("" : "+s"(F.vcu)); F.lane = F.tid & 63; F.wave = __builtin_amdgcn_readfirstlane(F.tid >> 6);
    const bf16* H = (const bf16*)(F.ws + WS_H); const float* PART = (const float*)(F.ws + WS_PART); bf16* AO = (bf16*)(F.ws + WS_AO);
    const float* subg = A.in[20] + (size_t)o_idx * 128;
    const int tid = F.tid, q = tid >> 5, v0 = (tid & 31) * 4;
    for (int bh = F.vcu; bh < SB * 16; bh += F.G) {
        const int b = bh >> 4, h = bh & 15; float oc[4] = {0.f, 0.f, 0.f, 0.f};
#pragma unroll
        for (int map = 0; map < 2; ++map) {
            const float* pb = PART + (size_t)((bh * 2 + map) * SA_NPART) * SA_PART_FLOATS;
            float M = -1e30f;
            for (int i = 0; i < SA_NPART; ++i) M = fmaxf(M, pb[(size_t)i * SA_PART_FLOATS + 2048 + q]);
            float l = 0.f, acc[4] = {0.f, 0.f, 0.f, 0.f};
            for (int i = 0; i < SA_NPART; ++i) { const float* pi = pb + (size_t)i * SA_PART_FLOATS; const float sc = __builtin_amdgcn_exp2f(pi[2048 + q] - M); l += pi[2048 + 16 + q] * sc;
#pragma unroll
                for (int j = 0; j < 4; ++j) acc[j] += pi[(v0 + j) * 16 + q] * sc; }
            const float coef = (map == 0 ? 1.f : -lam) / l;
#pragma unroll
            for (int j = 0; j < 4; ++j) oc[j] += acc[j] * coef;
        }
        float ss = oc[0] * oc[0] + oc[1] * oc[1] + oc[2] * oc[2] + oc[3] * oc[3];
        ss += __shfl_xor(ss, 1); ss += __shfl_xor(ss, 2); ss += __shfl_xor(ss, 4); ss += __shfl_xor(ss, 8); ss += __shfl_xor(ss, 16);
        const float rs = post / sqrtf(ss * (1.f / 128.f) + LN_EPS);
        const size_t row = (size_t)MP + b * SSEQ + q;
        const unsigned long long z = *(const GAS unsigned long long*)(H + row * 8192 + 6144 + h * 128 + v0); const unsigned zl = (unsigned)z, zh = (unsigned)(z >> 32);
        const f32x4 gq = *(const GAS f32x4*)(subg + v0);
        *(GAS unsigned long long*)(AO + row * 2048 + h * 128 + v0) = (unsigned long long)pk2(oc[0] * rs * gq.x * bflo(zl), oc[1] * rs * gq.y * bfhi(zl)) | ((unsigned long long)pk2(oc[2] * rs * gq.z * bflo(zh), oc[3] * rs * gq.w * bfhi(zh)) << 32);
    }
}
#ifndef ONLY
#define ONLY -1
#endif
#define PH(n) (ONLY < 0 || ONLY == (n))
#ifndef PROBE_MASK
#define PROBE_MASK 0
#endif
#define REP(n) for (int rep_ = 0; rep_ < (((PROBE_MASK >> (n)) & 1) ? 2 : 1); ++rep_)
__device__ __forceinline__ float lam_of(const Args& A, int o_idx, float lam_init) {
    float s1 = 0.f, s2 = 0.f;
    for (int i = 0; i < 64; ++i) { s1 += A.in[16][o_idx * 64 + i] * A.in[17][o_idx * 64 + i]; s2 += A.in[18][o_idx * 64 + i] * A.in[19][o_idx * 64 + i]; }
    return __expf(s1) - __expf(s2) + lam_init;
}
__global__ void __launch_bounds__(NWAVES * 64, 2) fwd_kernel(Args A) {
    extern __shared__ __attribute__((aligned(16))) unsigned char lds_raw[];
    Frame F;
    F.lds = (LAS unsigned char*)lds_raw;
    F.MISC = (volatile LAS unsigned*)(F.lds + MISC_OFF);
    F.tid = threadIdx.x; F.lane = F.tid & 63; F.wave = __builtin_amdgcn_readfirstlane(F.tid >> 6);
    F.G = gridDim.x; { const int bx = blockIdx.x; F.vcu = (F.G % 8 == 0) ? (bx % 8) * (F.G / 8) + bx / 8 : bx; }
    F.out = A.out; F.ws = A.ws;
    if (F.tid < 64) F.MISC[F.tid] = 0u;
    __syncthreads();
    XcdBarrier bar = xcd_barrier_post((unsigned*)(F.ws + WS_CTL) + CW_BAR, F.MISC + 8);

    bf16* XB = (bf16*)(F.ws + WS_XB); float* X = (float*)(F.ws + WS_X); float* Y = (float*)(F.ws + WS_Y); bf16* AO = (bf16*)(F.ws + WS_AO); bf16* H = (bf16*)(F.ws + WS_H);
    REP(0) if (PH(0)) p0_prologue(F, A);
    xcd_barrier(bar);
    for (int pr = 0; pr < 2; ++pr) {
        REP(1) if (PH(1)) { pg8::Gemm g{XB, (const bf16*)(F.ws + WS_WIE) + (size_t)pr * IN_EVEN * DM, MP, IN_EVEN, DM}; pg8::StaticOrder S; S.init(MP, IN_EVEN, F.G, (int)blockIdx.x);
          pg8::EpiPlain E{H, IN_EVEN}; pg8::gemm_phase<pg8::EpiPlain, pg8::StaticOrder, true, true>(F.lds, g, S, E);
          REP(14) small_gemm(F, XB + (size_t)MP * DM, g.Bt, IN_EVEN, DM, SEpiPlain{H, IN_EVEN}); }
        xcd_barrier(bar);
        REP(2) if (PH(2)) hgrn_prep_phase(F, A, pr);
        REP(3) if (PH(3)) conv_phase(F, A, pr);
        xcd_barrier(bar);
        REP(4) if (PH(4)) hgrn_scan_phase(F, A, pr);
        xcd_barrier(bar);
        REP(5) if (PH(5)) hgrn_combine_phase(F, A, pr);
        xcd_barrier(bar);
        REP(6) if (PH(6)) { pg8::Gemm g{AO, (const bf16*)(F.ws + WS_WOE) + (size_t)pr * DM * 2048, MP, DM, 2048}; pg8::StaticOrder S; S.init(MP, DM, F.G, (int)blockIdx.x);
          pg8::EpiRes E{X, Y, ALPHA_RES}; pg8::gemm_phase<pg8::EpiRes, pg8::StaticOrder, true, true>(F.lds, g, S, E);
          REP(14) small_gemm(F, AO + (size_t)MP * 2048, g.Bt, DM, 2048, SEpiRes{X, Y, ALPHA_RES}); }
        xcd_barrier(bar);
        REP(7) if (PH(7)) ln_phase(F, A, 2 * pr, false);
        xcd_barrier(bar);
        REP(8) if (PH(8)) { pg8::Gemm g{XB, (const bf16*)(F.ws + WS_WIO) + (size_t)pr * IN_ODD * DM, MP, IN_ODD, DM}; pg8::StaticOrder S; S.init(MP, IN_ODD, F.G, (int)blockIdx.x);
          pg8::EpiOdd E{H, F.out + OK_P + (size_t)pr * MP * 2048, F.out + OV_P + (size_t)pr * MP * 2048, F.out + OK_S + (size_t)pr * MS * 2048, F.out + OV_S + (size_t)pr * MS * 2048};
          pg8::gemm_phase<pg8::EpiOdd, pg8::StaticOrder, true, true>(F.lds, g, S, E);
          REP(14) small_gemm(F, XB + (size_t)MP * DM, g.Bt, IN_ODD, DM, SEpiOdd{H, E.ks, E.vs}); }
        xcd_barrier(bar);
        const float lam_init = pr == 0 ? 0.35550906759096924f : 0.55605820415755970f;
        const float lam = lam_of(A, pr, lam_init);
        REP(9) if (PH(9)) {
            const int npr = F.vcu < 2048 ? (2048 - F.vcu + F.G - 1) / F.G : 0; int sslot = F.vcu % 9; if (sslot > npr) sslot = npr;
            for (int i = 0, j = 0; i <= npr; ++i) {
                if (i == sslot) { sattn_phase(F, A, pr); continue; }
                const int idx = F.vcu + j * F.G; ++j;
                const int slot = idx >> 8, v = idx & 255, bh = v >> 2, s = v & 3, base = 4 * (slot >> 1) + s, qb = (slot & 1) ? 31 - base : base;
                att::attn_unit(H, AO, A.in[20] + (size_t)pr * 128, bh >> 4, bh & 15, qb, lam, 1.f - lam_init, (LAS char*)F.lds);
            }
        }
        xcd_barrier(bar);
        REP(11) if (PH(11)) sattn_combine_phase(F, A, pr, lam, 1.f - lam_init);
        xcd_barrier(bar);
        REP(12) if (PH(12)) { pg8::Gemm g{AO, (const bf16*)(F.ws + WS_WOO) + (size_t)pr * DM * 2048, MP, DM, 2048}; pg8::StaticOrder S; S.init(MP, DM, F.G, (int)blockIdx.x);
          pg8::EpiRes E{X, Y, ALPHA_RES}; pg8::gemm_phase<pg8::EpiRes, pg8::StaticOrder, true, true>(F.lds, g, S, E);
          REP(14) small_gemm(F, AO + (size_t)MP * 2048, g.Bt, DM, 2048, SEpiRes{X, Y, ALPHA_RES}); }
        xcd_barrier(bar);
        REP(13) if (PH(13)) ln_phase(F, A, 2 * pr + 1, pr == 1);
        if (pr == 0) xcd_barrier(bar);
    }
}

extern "C" void kernel_launch(void* const* d_in, const int* in_sizes, int n_in, void* d_out, int out_size, void* d_ws, size_t ws_size, hipStream_t stream) {
    static int grid = 0;
    if (grid == 0) {
        if (n_in != 23 || (size_t)out_size != OUT_TOTAL || ws_size < WS_END) { fprintf(stderr, "kernel_launch: unexpected shapes: n_in %d out %d ws %zu\n", n_in, out_size, ws_size); grid = -1; return; }
        int dev = 0, cus = 0;
        if (hipGetDevice(&dev) != hipSuccess || hipDeviceGetAttribute(&cus, hipDeviceAttributeMultiprocessorCount, dev) != hipSuccess) { grid = -1; return; }
        if (hipFuncSetAttribute((const void*)fwd_kernel, hipFuncAttributeMaxDynamicSharedMemorySize, LDS_BYTES) != hipSuccess) { fprintf(stderr, "kernel_launch: hipFuncSetAttribute failed\n"); grid = -1; return; }
        int per_cu = 0;
        if (hipOccupancyMaxActiveBlocksPerMultiprocessor(&per_cu, (const void*)fwd_kernel, NWAVES * 64, LDS_BYTES) != hipSuccess || per_cu < 1) fprintf(stderr, "kernel_launch: occupancy query reports %d\n", per_cu);
        (void)hipGetLastError();
        grid = cus;
    }
    if (grid < 0) return;
    if (hipMemsetAsync((char*)d_ws + WS_CTL, 0, CTL_ZERO_BYTES, stream) != hipSuccess) { fprintf(stderr, "kernel_launch: memset failed\n"); return; }
    Args a{};
    for (int i = 0; i < 23; ++i) a.in[i] = (const float*)d_in[i];
    a.out = (float*)d_out; a.ws = (unsigned char*)d_ws;
    hipLaunchKernelGGL(fwd_kernel, dim3(grid), dim3(NWAVES * 64), LDS_BYTES, stream, a);
    const hipError_t le = hipPeekAtLastError();
    if (le != hipSuccess) fprintf(stderr, "kernel_launch: launch failed: %s\n", hipGetErrorName(le));
}
```
